# Optimizing an MI355X kernel written in HIP

```python
import math
import jax, jax.numpy as jnp
from jax import lax
import numpy as np

D_MODEL = 1024
BATCH = 4
SEQ = 8192
DEPTH = 4

CTX_LEN = 256
GRID_W = 64
W_CONV = 512
W_HYENA = 512
HYENA_ORDER = 2
HYENA_EMB = 33
HYENA_BANDS = (HYENA_EMB - 1) // 2
HYENA_HID = 64
HYENA_FAST_DECAY = 0.3
HYENA_SLOW_DECAY = 1.5
HYENA_TARGET = 1e-2
N_HEADS = 8
QK_NOPE = 64
QK_ROPE = 32
V_HEAD = 64
Q_LORA = 384
KV_LORA = 256
W_MLA = N_HEADS * V_HEAD
ROPE_BASE = 10000.0
Q_BLOCK = 128
N_BRANCH = 3
EPS = 1e-6
IN_SPLITS = (W_CONV, W_CONV, W_CONV, W_CONV, 3 * W_HYENA, W_HYENA, Q_LORA, KV_LORA, QK_ROPE, W_MLA, N_BRANCH * D_MODEL)
N_IN = 4 * W_CONV + 4 * W_HYENA + Q_LORA + KV_LORA + QK_ROPE + W_MLA + N_BRANCH * D_MODEL

kernel_name = 'hybrid_conv_hyena_mla_prefix_trunk'


def rmsnorm(x, g):
    xf = x.astype(jnp.float32)
    y = xf * lax.rsqrt(jnp.mean(xf * xf, axis=-1, keepdims=True) + EPS)
    return (y * g.astype(jnp.float32)).astype(x.dtype)


def split_cols(p):
    outs = []
    o = 0
    for n in IN_SPLITS:
        outs.append(p[..., o:o + n])
        o += n
    return outs


def dwconv3(u, w, b):
    up = jnp.pad(u, ((0, 0), (1, 1), (0, 0)))
    return up[:, :-2] * w[0] + up[:, 1:-1] * w[1] + up[:, 2:] * w[2] + b


def axial_rope_tables(L):
    rows = L // GRID_W
    row = jnp.broadcast_to(jnp.arange(rows, dtype=jnp.float32)[:, None], (rows, GRID_W)).reshape(L)
    col = jnp.broadcast_to(jnp.arange(GRID_W, dtype=jnp.float32)[None, :], (rows, GRID_W)).reshape(L)
    n_f = QK_ROPE // 4
    inv = ROPE_BASE ** (-jnp.arange(n_f, dtype=jnp.float32) / n_f)
    ang = jnp.concatenate([row[:, None] * inv, col[:, None] * inv], axis=-1)
    return jnp.cos(ang), jnp.sin(ang)


def apply_rope(x, cos, sin):
    half = QK_ROPE // 2
    x1, x2 = x[..., :half], x[..., half:]
    c = cos[:, None, :].astype(x.dtype)
    s = sin[:, None, :].astype(x.dtype)
    return jnp.concatenate([x1 * c - x2 * s, x1 * s + x2 * c], axis=-1)


def mla_qkv(cq, ckv, kr, lp, rope):
    B, L = cq.shape[:2]
    q = (rmsnorm(cq, lp['mla_q_norm']) @ lp['mla_w_uq']).reshape(B, L, N_HEADS, QK_NOPE + QK_ROPE)
    qn, qr = q[..., :QK_NOPE], q[..., QK_NOPE:]
    kv = (rmsnorm(ckv, lp['mla_kv_norm']) @ lp['mla_w_ukv']).reshape(B, L, N_HEADS, QK_NOPE + V_HEAD)
    kn, v = kv[..., :QK_NOPE], kv[..., QK_NOPE:]
    kr = kr[:, :, None, :]
    if rope is not None:
        qr = apply_rope(qr, rope[0], rope[1])
        kr = apply_rope(kr, rope[0], rope[1])
    return qn, qr, kn, kr[:, :, 0], v


def attend(qn, qr, kn, kr, v):
    scale = (QK_NOPE + QK_ROPE) ** -0.5
    s = jnp.einsum('bqhd,bkhd->bhqk', qn, kn) + jnp.einsum('bqhr,bkr->bhqk', qr, kr)
    p = jax.nn.softmax(s.astype(jnp.float32) * scale, axis=-1).astype(v.dtype)
    return jnp.einsum('bhqk,bkhd->bqhd', p, v)


def attend_blocked(qn, qr, kn, kr, v):
    B, L = qn.shape[:2]
    nb = L // Q_BLOCK

    def blk(a):
        return a.reshape(B, nb, Q_BLOCK, *a.shape[2:]).swapaxes(0, 1)

    out = lax.map(lambda qs: attend(qs[0], qs[1], kn, kr, v), (blk(qn), blk(qr)))
    return out.swapaxes(0, 1).reshape(B, L, W_MLA)


def hyena_filter_fft(L, lp):
    dt = lp['hy_w1'].dtype
    t = jnp.linspace(0.0, 1.0, L, dtype=jnp.float32)[:, None]
    w = 2.0 * math.pi * jnp.arange(L, dtype=jnp.float32)[:, None] / L
    f = jnp.linspace(1e-4, HYENA_BANDS - 1, HYENA_BANDS, dtype=jnp.float32)[None, :]
    z = jnp.concatenate([t, jnp.cos(f * w), -jnp.sin(f * w)], axis=-1).astype(dt)
    hid = jnp.sin(lp['hy_freq'] * (z @ lp['hy_w1'] + lp['hy_b1']))
    hid = jnp.sin(lp['hy_freq'] * (hid @ lp['hy_w2'] + lp['hy_b2']))
    h = (hid @ lp['hy_w3']).astype(jnp.float32).reshape(L, 2, HYENA_ORDER, W_HYENA)
    max_decay = math.log(HYENA_TARGET) / HYENA_FAST_DECAY
    min_decay = math.log(HYENA_TARGET) / HYENA_SLOW_DECAY
    deltas = jnp.abs(jnp.linspace(min_decay, max_decay, W_HYENA, dtype=jnp.float32))
    h = h * jnp.exp(-t * deltas)[:, None, None, :]
    h = h / jnp.sum(jnp.abs(h), axis=(0, 1), keepdims=True)
    fwd = h[:, 0]
    bwd = h[1:, 1][::-1]
    k_full = jnp.concatenate([fwd, jnp.zeros((1, HYENA_ORDER, W_HYENA), jnp.float32), bwd], axis=0)
    return jnp.fft.rfft(k_full, axis=0)


def fftconv(u, kf, skip):
    L = u.shape[1]
    uf32 = u.astype(jnp.float32)
    uf = jnp.fft.rfft(uf32, n=2 * L, axis=1)
    y = jnp.fft.irfft(uf * kf[None], n=2 * L, axis=1)[:, :L]
    return (y + uf32 * skip.astype(jnp.float32)).astype(u.dtype)


def hyena_mix(hproj, lp, kf):
    u = dwconv3(hproj, lp['hy_conv_w'], lp['hy_conv_b'])
    v, x1, x2 = u[..., :W_HYENA], u[..., W_HYENA:2 * W_HYENA], u[..., 2 * W_HYENA:]
    z = x1 * fftconv(v, kf[:, 0], lp['hy_skip'][0])
    z = x2 * fftconv(z, kf[:, 1], lp['hy_skip'][1])
    return z


def merged_branches(parts, att, kf, lp):
    xin, gb, gc, za, hproj, zh, _cq, _ckv, _kr, zm, gates = parts
    ya = (jax.nn.silu(za) * (gb * dwconv3(gc * xin, lp['sc_conv_w'], lp['sc_conv_b']))) @ lp['sc_out']
    yh = (jax.nn.silu(zh) * hyena_mix(hproj, lp, kf)) @ lp['hy_out']
    ym = (jax.nn.silu(zm) * att) @ lp['mla_out']
    g = jax.nn.sigmoid(gates.reshape(*gates.shape[:-1], N_BRANCH, D_MODEL))
    y = g[..., 0, :] * ya + g[..., 1, :] * yh + g[..., 2, :] * ym
    return y @ lp['w_o']


def modulated_norm(x, g, mod):
    shift, scale, gate = mod[..., :D_MODEL], mod[..., D_MODEL:2 * D_MODEL], mod[..., 2 * D_MODEL:]
    return rmsnorm(x, g) * (1 + scale) + shift, gate


def setup_inputs(seed: int = 0) -> dict:
    key = jax.random.key(seed)
    ks = iter(jax.random.split(key, 32))

    def nrm(shape, s):
        return jax.random.normal(next(ks), shape, jnp.float32) * s

    D = D_MODEL
    return {
        'x': nrm((BATCH, SEQ, D), 1.0),
        'c': nrm((BATCH, D), 1.0),
        'ctx': nrm((BATCH, CTX_LEN, D), 1.0),
        'c_ctx': nrm((D,), 1.0),
        'ada_w': nrm((DEPTH, D, 3 * D), 0.5 * D ** -0.5),
        'ada_b': nrm((DEPTH, 3 * D), 0.02),
        'norm_g': 1.0 + nrm((DEPTH, D), 0.02),
        'w_in': nrm((DEPTH, D, N_IN), D ** -0.5),
        'b_in': nrm((DEPTH, N_IN), 0.02),
        'sc_conv_w': nrm((DEPTH, 3, W_CONV), 3 ** -0.5),
        'sc_conv_b': nrm((DEPTH, W_CONV), 0.02),
        'sc_out': nrm((DEPTH, W_CONV, D), W_CONV ** -0.5),
        'hy_conv_w': nrm((DEPTH, 3, 3 * W_HYENA), 3 ** -0.5),
        'hy_conv_b': nrm((DEPTH, 3 * W_HYENA), 0.02),
        'hy_w1': nrm((DEPTH, HYENA_EMB, HYENA_HID), HYENA_EMB ** -0.5),
        'hy_b1': nrm((DEPTH, HYENA_HID), 0.02),
        'hy_w2': nrm((DEPTH, HYENA_HID, HYENA_HID), HYENA_HID ** -0.5),
        'hy_b2': nrm((DEPTH, HYENA_HID), 0.02),
        'hy_w3': nrm((DEPTH, HYENA_HID, 2 * HYENA_ORDER * W_HYENA), HYENA_HID ** -0.5),
        'hy_freq': 1.0 + nrm((DEPTH, HYENA_HID), 0.1),
        'hy_skip': nrm((DEPTH, HYENA_ORDER, W_HYENA), 0.2),
        'hy_out': nrm((DEPTH, W_HYENA, D), W_HYENA ** -0.5),
        'mla_q_norm': 1.0 + nrm((DEPTH, Q_LORA), 0.02),
        'mla_w_uq': nrm((DEPTH, Q_LORA, N_HEADS * (QK_NOPE + QK_ROPE)), Q_LORA ** -0.5),
        'mla_kv_norm': 1.0 + nrm((DEPTH, KV_LORA), 0.02),
        'mla_w_ukv': nrm((DEPTH, KV_LORA, N_HEADS * (QK_NOPE + V_HEAD)), KV_LORA ** -0.5),
        'mla_out': nrm((DEPTH, W_MLA, D), W_MLA ** -0.5),
        'w_o': nrm((DEPTH, D, D), D ** -0.5),
        'final_g': 1.0 + nrm((D,), 0.02),
    }


def reference(x, c, ctx, c_ctx, ada_w, ada_b, norm_g, w_in, b_in, sc_conv_w, sc_conv_b, sc_out,
              hy_conv_w, hy_conv_b, hy_w1, hy_b1, hy_w2, hy_b2, hy_w3, hy_freq, hy_skip, hy_out,
              mla_q_norm, mla_w_uq, mla_kv_norm, mla_w_ukv, mla_out, w_o, final_g):
    B, L = x.shape[:2]
    Lc = ctx.shape[1]
    rope = axial_rope_tables(L)
    x_lat, x_ctx = x, ctx
    for i in range(DEPTH):
        lp = {
            'sc_conv_w': sc_conv_w[i], 'sc_conv_b': sc_conv_b[i], 'sc_out': sc_out[i],
            'hy_conv_w': hy_conv_w[i], 'hy_conv_b': hy_conv_b[i], 'hy_w1': hy_w1[i], 'hy_b1': hy_b1[i],
            'hy_w2': hy_w2[i], 'hy_b2': hy_b2[i], 'hy_w3': hy_w3[i], 'hy_freq': hy_freq[i],
            'hy_skip': hy_skip[i], 'hy_out': hy_out[i],
            'mla_q_norm': mla_q_norm[i], 'mla_w_uq': mla_w_uq[i], 'mla_kv_norm': mla_kv_norm[i],
            'mla_w_ukv': mla_w_ukv[i], 'mla_out': mla_out[i], 'w_o': w_o[i],
        }
        last = i == DEPTH - 1
        mod_l = (jax.nn.silu(c) @ ada_w[i] + ada_b[i])[:, None, :]
        mod_c = (jax.nn.silu(c_ctx) @ ada_w[i] + ada_b[i])[None, None, :]
        h_l, gate_l = modulated_norm(x_lat, norm_g[i], mod_l)
        h_c, gate_c = modulated_norm(x_ctx, norm_g[i], mod_c)
        parts_l = split_cols(h_l @ w_in[i] + b_in[i])
        parts_c = split_cols(h_c @ w_in[i] + b_in[i])
        qn_c, qr_c, kn_c, kr_c, v_c = mla_qkv(parts_c[6], parts_c[7], parts_c[8], lp, None)
        qn_l, qr_l, kn_l, kr_l, v_l = mla_qkv(parts_l[6], parts_l[7], parts_l[8], lp, rope)
        att_l = attend_blocked(qn_l, qr_l,
                               jnp.concatenate([kn_c, kn_l], axis=1),
                               jnp.concatenate([kr_c, kr_l], axis=1),
                               jnp.concatenate([v_c, v_l], axis=1))
        kf_l = hyena_filter_fft(L, lp)
        new_lat = x_lat + gate_l * merged_branches(parts_l, att_l, kf_l, lp)
        if not last:
            att_c = attend(qn_c, qr_c, kn_c, kr_c, v_c).reshape(B, Lc, W_MLA)
            kf_c = hyena_filter_fft(Lc, lp)
            x_ctx = x_ctx + gate_c * merged_branches(parts_c, att_c, kf_c, lp)
        x_lat = new_lat
    return rmsnorm(x_lat, final_g)
```

```cpp
#include <hip/hip_runtime.h>
#include <hip/hip_cooperative_groups.h>
#include <cstdio>
#include <cstdint>
namespace cg = cooperative_groups;

typedef unsigned short bf16_t;
using bf16x8 = __attribute__((ext_vector_type(8))) short;
using bf16x4 = __attribute__((ext_vector_type(4))) short;
using f32x4 = __attribute__((ext_vector_type(4))) float;
using u32x4 = __attribute__((ext_vector_type(4))) unsigned;
using u32x2 = __attribute__((ext_vector_type(2))) unsigned;
using f32x2 = __attribute__((ext_vector_type(2))) float;
typedef _Float16 h16x2_t __attribute__((ext_vector_type(2)));

constexpr int T2 = 16896;
constexpr int NPH_LAYER = 17;

constexpr size_t OFF_MODS = 0;
constexpr size_t OFF_HID2 = OFF_MODS + 245760;
constexpr size_t OFF_TW = OFF_HID2 + 8650752;
constexpr size_t OFF_XCTX = OFF_TW + 131072;
constexpr size_t OFF_WIN = OFF_XCTX + 4194304;
constexpr size_t OFF_WSC = OFF_WIN + 17104896;
constexpr size_t OFF_WHY = OFF_WSC + 1048576;
constexpr size_t OFF_WMLA = OFF_WHY + 1048576;
constexpr size_t OFF_WO = OFF_WMLA + 1048576;
constexpr size_t OFF_WUQ = OFF_WO + 2097152;
constexpr size_t OFF_WKN = OFF_WUQ + 589824;
constexpr size_t OFF_WV = OFF_WKN + 262144;
constexpr size_t OFF_SPEC = OFF_WV + 262144;
constexpr size_t OFF_HTC = OFF_SPEC + 134217728;
constexpr size_t OFF_PSUM = OFF_HTC + 2097152;
constexpr size_t OFF_PSUMC = OFF_PSUM + 1048576;
constexpr size_t OFF_HN = OFF_PSUMC + 32768;
constexpr size_t OFF_PA1 = OFF_HN + 34603008;
constexpr size_t OFF_PA2 = OFF_PA1 + 69206016;
constexpr size_t OFF_HT = OFF_PA2 + 40009728;
constexpr size_t OFF_Q = OFF_HT + 69206016;
constexpr size_t OFF_KF = OFF_Q + 25952256;
constexpr size_t OFF_VT = OFF_KF + 25952256;
constexpr size_t OFF_AA = OFF_VT + 17301504;
constexpr size_t OFF_AM = OFF_AA + 17301504;
constexpr size_t OFF_BAR = OFF_AM + 17301504;
constexpr size_t OFF_ROPE = OFF_BAR + 16384;
constexpr size_t WS_TOTAL = OFF_ROPE + 1048576;

struct Params {
  const float *x, *c, *ctx, *c_ctx, *ada_w, *ada_b, *norm_g, *w_in, *b_in, *sc_conv_w, *sc_conv_b, *sc_out, *hy_conv_w,
      *hy_conv_b, *hy_w1, *hy_b1, *hy_w2, *hy_b2, *hy_w3, *hy_freq, *hy_skip, *hy_out, *mla_q_norm, *mla_w_uq,
      *mla_kv_norm, *mla_w_ukv, *mla_out, *w_o, *final_g;
  float* out;
  char* ws;
};

typedef __bf16 bf16v2_t __attribute__((ext_vector_type(2)));
__device__ __forceinline__ unsigned pack2(float a, float b) {
  f32x2 v = {a, b};
  bf16v2_t r = __builtin_convertvector(v, bf16v2_t);
  return __builtin_bit_cast(unsigned, r);
}
__device__ __forceinline__ bf16_t f2bf(float f) { return (bf16_t)(pack2(f, 0.f) & 0xffffu); }
__device__ __forceinline__ float bf2f(bf16_t h) { return __uint_as_float(((unsigned)h) << 16); }
__device__ __forceinline__ float lo2f(unsigned u) { return __uint_as_float(u << 16); }
__device__ __forceinline__ float hi2f(unsigned u) { return __uint_as_float(u & 0xffff0000u); }
__device__ __forceinline__ float silu_f(float x) { return x / (1.f + __expf(-x)); }
__device__ __forceinline__ float sigm_f(float x) { return 1.f / (1.f + __expf(-x)); }
__device__ __forceinline__ int get_tid() {
  int t = threadIdx.x & 255;
  asm volatile("" : "+v"(t));
  return t;
}
__device__ __forceinline__ int get_tid512() {
  int t = threadIdx.x;
  asm volatile("" : "+v"(t));
  return t;
}
__device__ __forceinline__ float wave_sum(float v) {
#pragma unroll
  for (int m = 32; m >= 1; m >>= 1) v += __shfl_xor(v, m);
  return v;
}

template <int NI>
__device__ __forceinline__ void gemm_main(const bf16_t* __restrict__ A, int lda, const bf16_t* __restrict__ Bt, int ldb,
                                          int K, int m0, int n0, int nmax, f32x4 (&acc)[4][NI], char* smem) {
  constexpr int STAGE = (128 + 32 * NI) * 64;
  bf16_t* S0 = (bf16_t*)smem;
  const int tid = get_tid(), lane = tid & 63, wave = tid >> 6;
  const int wm = wave >> 1, wn = wave & 1, c = lane & 15, g = lane >> 4;
  const int lrow = tid >> 3, lkc = tid & 7;
  const int wsw = (lkc ^ ((lrow >> 1) & 7)) * 8;
  const int rsw = (c >> 1) & 7;
  u32x4 ra0[4], rb0[NI], ra1[4], rb1[NI];
  const bf16_t* ap = A + (size_t)(m0 + lrow) * lda + lkc * 8;
  const size_t astep = (size_t)32 * lda;
  const bf16_t* bp[NI];
#pragma unroll
  for (int i = 0; i < NI; ++i) {
    int br = n0 + lrow + i * 32;
    br = br < nmax ? br : nmax - 1;
    bp[i] = Bt + (size_t)br * ldb + lkc * 8;
  }
  const int nk = K >> 6;
#define GEMM_GLOAD(RA, RB, KT)                                                            \
  {                                                                                       \
    const int ko_ = ((KT) < nk ? (KT) : nk - 1) * 64;                                     \
    _Pragma("unroll") for (int i = 0; i < 4; ++i) RA[i] = *(const u32x4*)(ap + i * astep + ko_); \
    _Pragma("unroll") for (int i = 0; i < NI; ++i) RB[i] = *(const u32x4*)(bp[i] + ko_);  \
  }
#define GEMM_LSTORE(RA, RB, ST)                                                                            \
  {                                                                                                        \
    bf16_t* As_ = S0 + (ST) * STAGE;                                                                       \
    bf16_t* Bs_ = As_ + 128 * 64;                                                                          \
    _Pragma("unroll") for (int i = 0; i < 4; ++i) *(u32x4*)(As_ + (lrow + i * 32) * 64 + wsw) = RA[i];     \
    _Pragma("unroll") for (int i = 0; i < NI; ++i) *(u32x4*)(Bs_ + (lrow + i * 32) * 64 + wsw) = RB[i];    \
  }
#define GEMM_COMPUTE(ST)                                                                                                 \
  {                                                                                                                      \
    const bf16_t* As = S0 + (ST) * STAGE;                                                                                \
    const bf16_t* Bs = As + 128 * 64;                                                                                    \
    _Pragma("unroll") for (int kk = 0; kk < 2; ++kk) {                                                                   \
      bf16x8 af[4], bfr[NI];                                                                                             \
      const int ch = ((kk * 4 + g) ^ rsw) * 8;                                                                           \
      _Pragma("unroll") for (int mi = 0; mi < 4; ++mi) af[mi] = *(const bf16x8*)(As + (wm * 64 + mi * 16 + c) * 64 + ch); \
      _Pragma("unroll") for (int ni = 0; ni < NI; ++ni) bfr[ni] = *(const bf16x8*)(Bs + (wn * 16 * NI + ni * 16 + c) * 64 + ch); \
      _Pragma("unroll") for (int mi = 0; mi < 4; ++mi) _Pragma("unroll") for (int ni = 0; ni < NI; ++ni)                \
          acc[mi][ni] = __builtin_amdgcn_mfma_f32_16x16x32_bf16(bfr[ni], af[mi], acc[mi][ni], 0, 0, 0);                 \
    }                                                                                                                    \
  }
  GEMM_GLOAD(ra0, rb0, 0);
  GEMM_GLOAD(ra1, rb1, 1);
  __syncthreads();
  GEMM_LSTORE(ra0, rb0, 0);
  GEMM_GLOAD(ra0, rb0, 2);
  __syncthreads();
  for (int kt = 0; kt < nk; kt += 2) {
    GEMM_LSTORE(ra1, rb1, 1);
    GEMM_GLOAD(ra1, rb1, kt + 3);
    __builtin_amdgcn_sched_barrier(0);
    GEMM_COMPUTE(0);
    __syncthreads();
    if (kt + 2 < nk) GEMM_LSTORE(ra0, rb0, 0);
    GEMM_GLOAD(ra0, rb0, kt + 4);
    __builtin_amdgcn_sched_barrier(0);
    GEMM_COMPUTE(1);
    __syncthreads();
  }
#undef GEMM_COMPUTE
#undef GEMM_GLOAD
#undef GEMM_LSTORE
}

template <int NI>
__device__ __forceinline__ void zero_acc(f32x4 (&acc)[4][NI]) {
#pragma unroll
  for (int mi = 0; mi < 4; ++mi)
#pragma unroll
    for (int ni = 0; ni < NI; ++ni) acc[mi][ni] = f32x4{0.f, 0.f, 0.f, 0.f};
}

template <int MI, int NI, int WN>
__device__ __forceinline__ void gemm_t512(const bf16_t* __restrict__ A, int lda, const bf16_t* __restrict__ Bt, int ldb,
                                          int K, int m0, int n0, int nmax, f32x4 (&acc)[MI][NI], char* smem) {
  constexpr int BN = WN * NI * 16;
  constexpr int NB = BN / 64;
  constexpr int STAGE = (256 + BN) * 64;
  typedef __attribute__((address_space(3))) unsigned lds_u32;
  bf16_t* S0 = (bf16_t*)smem;
  const int tid = get_tid512(), lane = tid & 63, wave = tid >> 6;
  const int wm = wave / WN, wn = wave % WN, c = lane & 15, g = lane >> 4;
  const int lrow = tid >> 3, lkc = tid & 7;
  const int skc = (lkc ^ ((lrow >> 1) & 7)) * 8;
  const int rsw = (c >> 1) & 7;
  const bf16_t* ap = A + (size_t)(m0 + lrow) * lda + skc;
  const size_t astep = (size_t)64 * lda;
  int bo[NB];
#pragma unroll
  for (int i = 0; i < NB; ++i) {
    int br = n0 + lrow + i * 64;
    br = br < nmax ? br : nmax - 1;
    bo[i] = br * ldb + skc;
  }
  const int nk = K >> 6;
#define G5_GLDS(ST, KT)                                                                                         \
  {                                                                                                             \
    const int ko_ = (KT) * 64;                                                                                  \
    char* As_ = (char*)(S0 + (ST) * STAGE) + tid * 16;                                                          \
    char* Bs_ = As_ + 256 * 128;                                                                                \
    _Pragma("unroll") for (int i = 0; i < 4; ++i)                                                               \
        __builtin_amdgcn_global_load_lds((const unsigned*)(ap + i * astep + ko_), (lds_u32*)(As_ + i * 8192), 16, 0, 0); \
    _Pragma("unroll") for (int i = 0; i < NB; ++i)                                                              \
        __builtin_amdgcn_global_load_lds((const unsigned*)(Bt + (bo[i] + ko_)), (lds_u32*)(Bs_ + i * 8192), 16, 0, 0);   \
  }
  __syncthreads();
  G5_GLDS(0, 0);
  __syncthreads();
  for (int kt = 0; kt < nk; ++kt) {
    const int st = kt & 1;
    if (kt + 1 < nk) G5_GLDS(st ^ 1, kt + 1);
    const bf16_t* As = S0 + st * STAGE;
    const bf16_t* Bs = As + 256 * 64;
#pragma unroll
    for (int kk = 0; kk < 2; ++kk) {
      bf16x8 bfr[NI];
      const int ch = ((kk * 4 + g) ^ rsw) * 8;
#pragma unroll
      for (int ni = 0; ni < NI; ++ni) bfr[ni] = *(const bf16x8*)(Bs + (wn * NI * 16 + ni * 16 + c) * 64 + ch);
#pragma unroll
      for (int mi = 0; mi < MI; ++mi) {
        const bf16x8 af = *(const bf16x8*)(As + (wm * MI * 16 + mi * 16 + c) * 64 + ch);
#pragma unroll
        for (int ni = 0; ni < NI; ++ni)
          acc[mi][ni] = __builtin_amdgcn_mfma_f32_16x16x32_bf16(bfr[ni], af, acc[mi][ni], 0, 0, 0);
      }
    }
    asm volatile("s_waitcnt vmcnt(0)" ::: "memory");
    __syncthreads();
  }
#undef G5_GLDS
}

#define EPI_LOOP(NI_)                                                                                   \
  const int _tid = get_tid(), _lane = _tid & 63, _wave = _tid >> 6, _wm = _wave >> 1, _wn = _wave & 1;    \
  _Pragma("unroll") for (int mi = 0; mi < 4; ++mi) _Pragma("unroll") for (int ni = 0; ni < NI_; ++ni)

#define EPI_ROW (m0 + _wm * 64 + mi * 16 + (_lane & 15))
#define EPI_COL(NI_) (n0 + _wn * 16 * NI_ + ni * 16 + (_lane >> 4) * 4)

__device__ __forceinline__ void store_bf4(bf16_t* dst, f32x4 v) {
  u32x2 u;
  u[0] = pack2(v[0], v[1]);
  u[1] = pack2(v[2], v[3]);
  *(u32x2*)dst = u;
}

__device__ __forceinline__ void job_mods(const Params& p, int j, char* smem) {
  float* s = (float*)smem;
  float* red = s + 5 * 1024;
  const int layer = j / 48, chunk = j % 48, tid = get_tid();
  __syncthreads();
  for (int i = tid; i < 5 * 1024; i += 256) {
    int v = i >> 10, k = i & 1023;
    float cv = (v < 4) ? p.c[v * 1024 + k] : p.c_ctx[k];
    s[i] = silu_f(cv);
  }
  __syncthreads();
  const int col = tid & 63, kg = tid >> 6;
  const int n = chunk * 64 + col;
  const float* w = p.ada_w + (size_t)layer * 1024 * 3072 + (size_t)(kg * 256) * 3072 + n;
  float a0 = 0, a1 = 0, a2 = 0, a3 = 0, a4 = 0;
#pragma unroll 8
  for (int k = 0; k < 256; ++k) {
    float wv = w[(size_t)k * 3072];
    const int kk = kg * 256 + k;
    a0 += s[kk] * wv;
    a1 += s[1024 + kk] * wv;
    a2 += s[2048 + kk] * wv;
    a3 += s[3072 + kk] * wv;
    a4 += s[4096 + kk] * wv;
  }
  red[(kg * 5 + 0) * 64 + col] = a0;
  red[(kg * 5 + 1) * 64 + col] = a1;
  red[(kg * 5 + 2) * 64 + col] = a2;
  red[(kg * 5 + 3) * 64 + col] = a3;
  red[(kg * 5 + 4) * 64 + col] = a4;
  __syncthreads();
  if (tid < 64) {
    float b = p.ada_b[layer * 3072 + n];
    float* mods = (float*)(p.ws + OFF_MODS) + layer * 5 * 3072;
#pragma unroll
    for (int v = 0; v < 5; ++v)
      mods[v * 3072 + n] = red[(0 * 5 + v) * 64 + col] + red[(1 * 5 + v) * 64 + col] + red[(2 * 5 + v) * 64 + col] + red[(3 * 5 + v) * 64 + col] + b;
  }
}

__device__ __forceinline__ void job_hid(const Params& p, int j, char* smem) {
  float* zs = (float*)smem;
  float* h1 = zs + 160;
  const int layer = j / 2112, rb = j % 2112, tid = get_tid(), li = tid >> 6, jj = tid & 63;
  const int R = rb * 4 + li;
  const int L = (R < 8192) ? 8192 : 256;
  const int l = (R < 8192) ? R : R - 8192;
  __syncthreads();
  if (jj < 33) {
    float val;
    if (jj == 0) {
      val = (float)l / (float)(L - 1);
    } else {
      int b = (jj - 1) & 15;
      float f = 1e-4f + (float)b * ((15.0f - 1e-4f) / 15.0f);
      float w = 6.283185307179586f * (float)l / (float)L;
      float a = f * w;
      val = (jj <= 16) ? cosf(a) : -sinf(a);
    }
    zs[li * 40 + jj] = val;
  }
  __syncthreads();
  const float* w1 = p.hy_w1 + layer * 33 * 64;
  const float* w2 = p.hy_w2 + layer * 64 * 64;
  float a = p.hy_b1[layer * 64 + jj];
  for (int k = 0; k < 33; ++k) a += zs[li * 40 + k] * w1[k * 64 + jj];
  const float fr = p.hy_freq[layer * 64 + jj];
  h1[li * 64 + jj] = sinf(fr * a);
  __syncthreads();
  float a2 = p.hy_b2[layer * 64 + jj];
  for (int k = 0; k < 64; ++k) a2 += h1[li * 64 + k] * w2[k * 64 + jj];
  float* hid2 = (float*)(p.ws + OFF_HID2);
  hid2[((size_t)layer * 8448 + R) * 64 + jj] = sinf(fr * a2);
}

__device__ __forceinline__ void job_tw(const Params& p, int j) {
  const int k = j * 256 + get_tid();
  float sn, cs;
  sincospif((float)k / 8192.0f, &sn, &cs);
  float2* tw = (float2*)(p.ws + OFF_TW);
  tw[k] = make_float2(cs, -sn);
}

__device__ __forceinline__ void job_rope(const Params& p, int j) {
  const int idx = j * 256 + get_tid();
  const int t = idx >> 4, jj = idx & 15;
  const float pos = (jj < 8) ? (float)(t >> 6) : (float)(t & 63);
  const float inv = powf(10000.0f, -(float)(jj & 7) / 8.0f);
  float sn, cs;
  sincosf(pos * inv, &sn, &cs);
  ((float2*)(p.ws + OFF_ROPE))[idx] = make_float2(cs, sn);
}

__device__ __forceinline__ void tr_tile(const float* src, int ld, int nvalid, int k0, bf16_t* dst, int ldd, char* smem) {
  float* ts = (float*)smem;
  const int tid = get_tid(), a = tid & 63, b4 = tid >> 6;
  __syncthreads();
#pragma unroll 4
  for (int i = 0; i < 16; ++i) {
    int k = i * 4 + b4;
    ts[k * 65 + a] = (a < nvalid) ? src[(size_t)(k0 + k) * ld + a] : 0.f;
  }
  __syncthreads();
#pragma unroll 4
  for (int i = 0; i < 16; ++i) {
    int n = i * 4 + b4;
    if (n < nvalid) dst[(size_t)n * ldd + k0 + a] = f2bf(ts[a * 65 + n]);
  }
}

__device__ __forceinline__ void job_hgen(const Params& p, int layer, int jj, char* smem) {
  bf16_t* Ah = (bf16_t*)smem;
  bf16_t* Al = Ah + 64 * 72;
  const int tid = get_tid(), lane = tid & 63, wave = tid >> 6, c = lane & 15, g = lane >> 4;
  const bool isc = jj >= 1024;
  const int q = isc ? jj - 1024 : jj;
  const int lb = q >> 3, cc = q & 7;
  const int L = isc ? 256 : 8192;
  const int l0 = lb * 64;
  const float* hid2 = (const float*)(p.ws + OFF_HID2) + ((size_t)layer * 8448 + (isc ? 8192 : 0) + l0) * 64;
  __syncthreads();
  for (int i = tid; i < 2048; i += 256) {
    const int r = i >> 5, k2 = (i & 31) * 2;
    const f32x2 v = *(const f32x2*)(hid2 + r * 64 + k2);
    const unsigned hi = pack2(v[0], v[1]);
    const unsigned lo = pack2(v[0] - lo2f(hi), v[1] - hi2f(hi));
    *(unsigned*)(Ah + r * 72 + k2) = hi;
    *(unsigned*)(Al + r * 72 + k2) = lo;
  }
  const int colw = cc * 256 + wave * 64;
  const float* w3 = p.hy_w3 + (size_t)layer * 64 * 2048 + colw + c;
  bf16x8 bh[2][4], bl[2][4];
#pragma unroll
  for (int ks = 0; ks < 2; ++ks)
#pragma unroll
    for (int ni = 0; ni < 4; ++ni) {
      float wv[8];
#pragma unroll
      for (int e = 0; e < 8; ++e) wv[e] = w3[(size_t)(ks * 32 + g * 8 + e) * 2048 + ni * 16];
      u32x4 h4, l4;
#pragma unroll
      for (int e2 = 0; e2 < 4; ++e2) {
        const unsigned hi = pack2(wv[2 * e2], wv[2 * e2 + 1]);
        h4[e2] = hi;
        l4[e2] = pack2(wv[2 * e2] - lo2f(hi), wv[2 * e2 + 1] - hi2f(hi));
      }
      bh[ks][ni] = __builtin_bit_cast(bf16x8, h4);
      bl[ks][ni] = __builtin_bit_cast(bf16x8, l4);
    }
  __syncthreads();
  f32x4 acc[4][4];
#pragma unroll
  for (int mi = 0; mi < 4; ++mi)
#pragma unroll
    for (int ni = 0; ni < 4; ++ni) acc[mi][ni] = f32x4{0.f, 0.f, 0.f, 0.f};
#pragma unroll
  for (int ks = 0; ks < 2; ++ks)
#pragma unroll
    for (int mi = 0; mi < 4; ++mi) {
      const bf16x8 ah = *(const bf16x8*)(Ah + (mi * 16 + c) * 72 + ks * 32 + g * 8);
      const bf16x8 al = *(const bf16x8*)(Al + (mi * 16 + c) * 72 + ks * 32 + g * 8);
#pragma unroll
      for (int ni = 0; ni < 4; ++ni) {
        acc[mi][ni] = __builtin_amdgcn_mfma_f32_16x16x32_bf16(bl[ks][ni], ah, acc[mi][ni], 0, 0, 0);
        acc[mi][ni] = __builtin_amdgcn_mfma_f32_16x16x32_bf16(bh[ks][ni], al, acc[mi][ni], 0, 0, 0);
        acc[mi][ni] = __builtin_amdgcn_mfma_f32_16x16x32_bf16(bh[ks][ni], ah, acc[mi][ni], 0, 0, 0);
      }
    }
  const float mind = -3.0701134573253945f, maxd = -15.350567286626973f;
  float* outb = isc ? (float*)(p.ws + OFF_HTC) : (float*)(p.ws + OFF_PA1);
  const int ldo = isc ? 256 : 8192;
  float* psb = isc ? ((float*)(p.ws + OFF_PSUMC) + lb * 2048) : ((float*)(p.ws + OFF_PSUM) + lb * 2048);
#pragma unroll
  for (int ni = 0; ni < 4; ++ni)
#pragma unroll
    for (int j = 0; j < 4; ++j) {
      const int col = colw + ni * 16 + g * 4 + j;
      const float delta = fabsf(mind + (float)(col & 511) * ((maxd - mind) / 511.0f));
      float sum = 0.f;
#pragma unroll
      for (int mi = 0; mi < 4; ++mi) {
        const int lag = l0 + mi * 16 + c;
        const float t = (float)lag / (float)(L - 1);
        const float v = acc[mi][ni][j] * __expf(-t * delta);
        sum += fabsf(v);
        outb[(size_t)col * ldo + lag] = v;
      }
      sum += __shfl_xor(sum, 1);
      sum += __shfl_xor(sum, 2);
      sum += __shfl_xor(sum, 4);
      sum += __shfl_xor(sum, 8);
      if (c == 0) psb[col] = sum;
    }
}

typedef f32x2 C;
__device__ __forceinline__ C cmul(C a, C b) { return C{a[0] * b[0] - a[1] * b[1], a[0] * b[1] + a[1] * b[0]}; }
__device__ __forceinline__ C cmulc(C a, C b) { return C{a[0] * b[0] + a[1] * b[1], a[1] * b[0] - a[0] * b[1]}; }
__device__ __forceinline__ C cmuli_neg(C a) { return C{a[1], -a[0]}; }
__device__ __forceinline__ C cis_rev(float r) { return C{__builtin_amdgcn_cosf(r), __builtin_amdgcn_sinf(r)}; }

template <int S8>
__device__ __forceinline__ void r8_fwd_pass(float2* sm, const int tid) {
  const float h = 0.70710678118654752f;
#pragma unroll 2
  for (int b = 0; b < 4; ++b) {
    const int bidx = tid + 256 * b;
    const int j = bidx & (S8 - 1);
    const int base = ((bidx - j) << 3) + j;
    C x[8];
#pragma unroll
    for (int q = 0; q < 8; ++q) { float2 v = sm[base + q * S8]; x[q] = C{v.x, v.y}; }
    const C T1 = cis_rev(-(float)j * (1.0f / (float)(8 * S8)));
    const C T2 = cmul(T1, T1), T3 = cmul(T2, T2);
    const C tw1[4] = {T1, cmul(T1, C{h, -h}), cmuli_neg(T1), cmul(T1, C{-h, -h})};
#pragma unroll
    for (int q = 0; q < 4; ++q) { C a = x[q], d = x[q + 4]; x[q] = a + d; x[q + 4] = cmul(a - d, tw1[q]); }
    const C T2i = cmuli_neg(T2);
#pragma unroll
    for (int g = 0; g < 8; g += 4) {
      { C a = x[g], d = x[g + 2]; x[g] = a + d; x[g + 2] = cmul(a - d, T2); }
      { C a = x[g + 1], d = x[g + 3]; x[g + 1] = a + d; x[g + 3] = cmul(a - d, T2i); }
    }
#pragma unroll
    for (int q = 0; q < 8; q += 2) { C a = x[q], d = x[q + 1]; x[q] = a + d; x[q + 1] = cmul(a - d, T3); }
#pragma unroll
    for (int q = 0; q < 8; ++q) sm[base + q * S8] = make_float2(x[q][0], x[q][1]);
  }
  __syncthreads();
}

template <int S8>
__device__ __forceinline__ void r8_inv_pass(float2* sm, const int tid) {
  const float h = 0.70710678118654752f;
#pragma unroll 2
  for (int b = 0; b < 4; ++b) {
    const int bidx = tid + 256 * b;
    const int j = bidx & (S8 - 1);
    const int base = ((bidx - j) << 3) + j;
    C x[8];
#pragma unroll
    for (int q = 0; q < 8; ++q) { float2 v = sm[base + q * S8]; x[q] = C{v.x, v.y}; }
    const C T1 = cis_rev(-(float)j * (1.0f / (float)(8 * S8)));
    const C T2 = cmul(T1, T1), T3 = cmul(T2, T2);
#pragma unroll
    for (int q = 0; q < 8; q += 2) { C a = x[q], d = cmulc(x[q + 1], T3); x[q] = a + d; x[q + 1] = a - d; }
    const C T2i = cmuli_neg(T2);
#pragma unroll
    for (int g = 0; g < 8; g += 4) {
      { C a = x[g], d = cmulc(x[g + 2], T2); x[g] = a + d; x[g + 2] = a - d; }
      { C a = x[g + 1], d = cmulc(x[g + 3], T2i); x[g + 1] = a + d; x[g + 3] = a - d; }
    }
    const C tw1[4] = {T1, cmul(T1, C{h, -h}), cmuli_neg(T1), cmul(T1, C{-h, -h})};
#pragma unroll
    for (int q = 0; q < 4; ++q) { C a = x[q], d = cmulc(x[q + 4], tw1[q]); x[q] = a + d; x[q + 4] = a - d; }
#pragma unroll
    for (int q = 0; q < 8; ++q) sm[base + q * S8] = make_float2(x[q][0], x[q][1]);
  }
  __syncthreads();
}

#define W16X(k) ((k) == 0 ? 1.0f : (k) == 1 ? 0.92387953251128674f : (k) == 2 ? 0.70710678118654752f : (k) == 3 ? 0.38268343236508977f : (k) == 4 ? 0.0f : (k) == 5 ? -0.38268343236508977f : (k) == 6 ? -0.70710678118654752f : -0.92387953251128674f)
#define W16Y(k) ((k) == 0 ? 0.0f : (k) == 1 ? -0.38268343236508977f : (k) == 2 ? -0.70710678118654752f : (k) == 3 ? -0.92387953251128674f : (k) == 4 ? -1.0f : (k) == 5 ? -0.92387953251128674f : (k) == 6 ? -0.70710678118654752f : -0.38268343236508977f)

__device__ __forceinline__ void fwd16(C (&e)[16]) {
#pragma unroll
  for (int k = 0; k < 8; ++k) { C a = e[k], d = e[k + 8]; e[k] = a + d; e[k + 8] = cmul(a - d, C{W16X(k), W16Y(k)}); }
#pragma unroll
  for (int g = 0; g < 16; g += 8)
#pragma unroll
    for (int k = 0; k < 4; ++k) { C a = e[g + k], d = e[g + k + 4]; e[g + k] = a + d; e[g + k + 4] = cmul(a - d, C{W16X(2 * k), W16Y(2 * k)}); }
#pragma unroll
  for (int g = 0; g < 16; g += 4)
#pragma unroll
    for (int k = 0; k < 2; ++k) { C a = e[g + k], d = e[g + k + 2]; e[g + k] = a + d; e[g + k + 2] = cmul(a - d, C{W16X(4 * k), W16Y(4 * k)}); }
#pragma unroll
  for (int k = 0; k < 16; k += 2) { C a = e[k], d = e[k + 1]; e[k] = a + d; e[k + 1] = a - d; }
}
__device__ __forceinline__ void inv16(C (&e)[16]) {
#pragma unroll
  for (int k = 0; k < 16; k += 2) { C a = e[k], d = e[k + 1]; e[k] = a + d; e[k + 1] = a - d; }
#pragma unroll
  for (int g = 0; g < 16; g += 4)
#pragma unroll
    for (int k = 0; k < 2; ++k) { C a = e[g + k], d = cmulc(e[g + k + 2], C{W16X(4 * k), W16Y(4 * k)}); e[g + k] = a + d; e[g + k + 2] = a - d; }
#pragma unroll
  for (int g = 0; g < 16; g += 8)
#pragma unroll
    for (int k = 0; k < 4; ++k) { C a = e[g + k], d = cmulc(e[g + k + 4], C{W16X(2 * k), W16Y(2 * k)}); e[g + k] = a + d; e[g + k + 4] = a - d; }
#pragma unroll
  for (int k = 0; k < 8; ++k) { C a = e[k], d = cmulc(e[k + 8], C{W16X(k), W16Y(k)}); e[k] = a + d; e[k + 8] = a - d; }
}

__device__ __forceinline__ void ld16(const float2* src, C (&e)[16]) {
#pragma unroll
  for (int k = 0; k < 8; ++k) {
    f32x4 v = *(const f32x4*)(src + 2 * k);
    e[2 * k] = C{v[0], v[1]};
    e[2 * k + 1] = C{v[2], v[3]};
  }
}
__device__ __forceinline__ void st16(float2* dst, const C (&e)[16]) {
#pragma unroll
  for (int k = 0; k < 8; ++k) *(f32x4*)(dst + 2 * k) = f32x4{e[2 * k][0], e[2 * k][1], e[2 * k + 1][0], e[2 * k + 1][1]};
}

__device__ __forceinline__ void fft_fwd_to_global(float2* sm, const int tid, float2* __restrict__ dst, float scale) {
  r8_fwd_pass<1024>(sm, tid);
  r8_fwd_pass<128>(sm, tid);
  r8_fwd_pass<16>(sm, tid);
#pragma unroll 1
  for (int bb = 0; bb < 2; ++bb) {
    const int blk = tid + 256 * bb;
    C e[16];
    ld16(sm + 16 * blk, e);
    fwd16(e);
#pragma unroll
    for (int k = 0; k < 16; ++k) e[k] *= scale;
    st16(dst + 16 * blk, e);
  }
}

__device__ __forceinline__ void fft_conv_core(float2* sm, const int tid, const float2* __restrict__ sp) {
  r8_fwd_pass<1024>(sm, tid);
  r8_fwd_pass<128>(sm, tid);
  r8_fwd_pass<16>(sm, tid);
#pragma unroll 1
  for (int bb = 0; bb < 2; ++bb) {
    const int blk = tid + 256 * bb;
    C e[16], kk[16];
    ld16(sp + 16 * blk, kk);
    ld16(sm + 16 * blk, e);
    fwd16(e);
#pragma unroll
    for (int k = 0; k < 16; ++k) e[k] = cmul(e[k], kk[k]);
    inv16(e);
    st16(sm + 16 * blk, e);
  }
  __syncthreads();
  r8_inv_pass<16>(sm, tid);
  r8_inv_pass<128>(sm, tid);
  r8_inv_pass<1024>(sm, tid);
}

__device__ __forceinline__ void fft_fwd_inplace(float2* sm, const int tid) {
  r8_fwd_pass<1024>(sm, tid);
  r8_fwd_pass<128>(sm, tid);
  r8_fwd_pass<16>(sm, tid);
#pragma unroll 1
  for (int bb = 0; bb < 2; ++bb) {
    const int blk = tid + 256 * bb;
    C e[16];
    ld16(sm + 16 * blk, e);
    fwd16(e);
    st16(sm + 16 * blk, e);
  }
  __syncthreads();
}

__device__ __forceinline__ void job_filtfft(const Params& p, int j, char* smem) {
  float2* sm = (float2*)smem;
  float* red = (float*)smem;
  const int tid = get_tid();
  const int par = j & 1, c = j >> 1;
  const float* psum = (const float*)(p.ws + OFF_PSUM);
  const float2* tw = (const float2*)(p.ws + OFF_TW);
  __syncthreads();
  float v0 = 0.f, v1 = 0.f;
  if (tid < 128) {
    v0 = psum[tid * 2048 + c] + psum[tid * 2048 + 1024 + c];
    v1 = psum[tid * 2048 + 512 + c] + psum[tid * 2048 + 1536 + c];
  }
  v0 = wave_sum(v0);
  v1 = wave_sum(v1);
  if ((tid & 63) == 0) { red[(tid >> 6) * 2] = v0; red[(tid >> 6) * 2 + 1] = v1; }
  __syncthreads();
  const float S0 = red[0] + red[2] + red[4] + red[6];
  const float S1 = red[1] + red[3] + red[5] + red[7];
  __syncthreads();
  const float* hf = (const float*)(p.ws + OFF_PA1);
  const float* h00 = hf + (size_t)c * 8192;
  const float* h01 = hf + (size_t)(512 + c) * 8192;
  const float* h10 = hf + (size_t)(1024 + c) * 8192;
  const float* h11 = hf + (size_t)(1536 + c) * 8192;
#pragma unroll 4
  for (int i = 0; i < 32; ++i) {
    const int n = tid + 256 * i;
    const float a0 = h00[n], a1 = h01[n];
    const float b0 = (n >= 1) ? h10[8192 - n] : 0.f;
    const float b1 = (n >= 1) ? h11[8192 - n] : 0.f;
    if (par == 0) {
      sm[n] = make_float2(a0 + b0, a1 + b1);
    } else {
      const float d0 = a0 - b0, d1 = a1 - b1;
      const float2 w = tw[n];
      sm[n] = make_float2(d0 * w.x - d1 * w.y, d0 * w.y + d1 * w.x);
    }
  }
  __syncthreads();
  fft_fwd_inplace(sm, tid);
  const float i0 = 0.5f / S0, i1 = 0.5f / S1;
  float2* spec0 = (float2*)(p.ws + OFF_SPEC) + (size_t)(c * 2 + par) * 8192;
  float2* spec1 = (float2*)(p.ws + OFF_SPEC) + (size_t)((512 + c) * 2 + par) * 8192;
#pragma unroll 4
  for (int i = 0; i < 32; ++i) {
    const int pidx = tid + 256 * i;
    const int m = (int)(__brev((unsigned)pidx) >> 19);
    const int mp = par ? (8191 - m) : ((8192 - m) & 8191);
    const int pp = (int)(__brev((unsigned)mp) >> 19);
    const float2 z1 = sm[pidx], z2 = sm[pp];
    spec0[pidx] = make_float2((z1.x + z2.x) * i0, (z1.y - z2.y) * i0);
    spec1[pidx] = make_float2((z1.y + z2.y) * i1, (z2.x - z1.x) * i1);
  }
}

__device__ __forceinline__ float ht_conv(const bf16_t* row, int t, int Lseg, float w0, float w1, float w2, float b) {
  float hm = (t > 0) ? bf2f(row[t - 1]) : 0.f;
  float h0 = bf2f(row[t]);
  float hp = (t < Lseg - 1) ? bf2f(row[t + 1]) : 0.f;
  return w0 * hm + w1 * h0 + w2 * hp + b;
}

__device__ __forceinline__ void load8_seq(const bf16_t* row, int n0, bool doconv, float w0, float w1, float w2, float b,
                                          float (&out)[8]) {
  const u32x4 v = *(const u32x4*)(row + n0);
  float h[10];
#pragma unroll
  for (int k = 0; k < 4; ++k) { h[1 + 2 * k] = lo2f(v[k]); h[2 + 2 * k] = hi2f(v[k]); }
  if (doconv) {
    h[0] = (n0 > 0) ? bf2f(row[n0 - 1]) : 0.f;
    h[9] = (n0 + 8 < 8192) ? bf2f(row[n0 + 8]) : 0.f;
#pragma unroll
    for (int k = 0; k < 8; ++k) out[k] = w0 * h[k] + w1 * h[k + 1] + w2 * h[k + 2] + b;
  } else {
#pragma unroll
    for (int k = 0; k < 8; ++k) out[k] = h[k + 1];
  }
}

__device__ __forceinline__ void job_fftconv(const Params& p, int layer, int c, int which, char* smem) {
  float2* sm = (float2*)smem;
  const int tid = get_tid();
  bf16_t* HT = (bf16_t*)(p.ws + OFF_HT);
  const float2* spec = (const float2*)(p.ws + OFF_SPEC) + (size_t)((which * 512 + c) * 2) * 8192;
  const float* cw = p.hy_conv_w + layer * 3 * 1536;
  const float* cb = p.hy_conv_b + layer * 1536;
  const int cx = (which == 0) ? 512 + c : 1024 + c;
  const float uw0 = cw[c], uw1 = cw[1536 + c], uw2 = cw[3072 + c], ub = cb[c];
  const float xw0 = cw[cx], xw1 = cw[1536 + cx], xw2 = cw[3072 + cx], xb = cb[cx];
  const float skip = p.hy_skip[layer * 1024 + which * 512 + c];
  bf16_t* urow = HT + (size_t)c * T2;
  const bf16_t* xrow = HT + (size_t)cx * T2;
  const bf16_t* zrow = HT + (size_t)(1536 + c) * T2;
  const bool uconv = (which == 0);
  f32x2 y[32];
  for (int par = 0; par < 2; ++par) {
    __syncthreads();
#pragma unroll 1
    for (int i = 0; i < 4; ++i) {
      const int n0 = tid * 8 + 2048 * i;
      float a0[8], a1[8];
      load8_seq(urow, n0, uconv, uw0, uw1, uw2, ub, a0);
      load8_seq(urow + 8192, n0, uconv, uw0, uw1, uw2, ub, a1);
#pragma unroll
      for (int k = 0; k < 8; k += 2) {
        C z0 = C{a0[k], a1[k]}, z1 = C{a0[k + 1], a1[k + 1]};
        if (par == 1) {
          z0 = cmul(z0, cis_rev(-(float)(n0 + k) * (1.0f / 16384.0f)));
          z1 = cmul(z1, cis_rev(-(float)(n0 + k + 1) * (1.0f / 16384.0f)));
        }
        *(f32x4*)(sm + n0 + k) = f32x4{z0[0], z0[1], z1[0], z1[1]};
      }
    }
    __syncthreads();
    fft_conv_core(sm, tid, spec + par * 8192);
    if (par == 0) {
#pragma unroll
      for (int i = 0; i < 32; ++i) { float2 z = sm[tid + 256 * i]; y[i][0] = z.x; y[i][1] = z.y; if ((i & 7) == 7) __builtin_amdgcn_sched_barrier(0); }
    } else {
#pragma unroll 4
      for (int i = 0; i < 32; ++i) {
        const int n = tid + 256 * i;
        float2 z = sm[n];
        C w = cis_rev(-(float)n * (1.0f / 16384.0f));
        sm[n] = make_float2(z.x * w[0] + z.y * w[1], z.y * w[0] - z.x * w[1]);
      }
#pragma unroll
      for (int i = 0; i < 32; ++i) {
        const int n = tid + 256 * i;
        float2 z = sm[n];
        sm[n] = make_float2(y[i][0] + z.x, y[i][1] + z.y);
        if ((i & 7) == 7) __builtin_amdgcn_sched_barrier(0);
      }
    }
  }
  __syncthreads();
  const float sc = 1.0f / 16384.0f;
#pragma unroll 1
  for (int i = 0; i < 4; ++i) {
    const int n0 = tid * 8 + 2048 * i;
    float u0[8], u1[8], x0[8], x1[8], g0[8], g1[8];
    load8_seq(urow, n0, uconv, uw0, uw1, uw2, ub, u0);
    load8_seq(urow + 8192, n0, uconv, uw0, uw1, uw2, ub, u1);
    load8_seq(xrow, n0, true, xw0, xw1, xw2, xb, x0);
    load8_seq(xrow + 8192, n0, true, xw0, xw1, xw2, xb, x1);
    if (which == 1) {
      load8_seq(zrow, n0, false, 0.f, 0.f, 0.f, 0.f, g0);
      load8_seq(zrow + 8192, n0, false, 0.f, 0.f, 0.f, 0.f, g1);
    }
#pragma unroll
    for (int k = 0; k < 8; k += 2) {
      f32x4 yy = *(const f32x4*)(sm + n0 + k);
      float v00 = (yy[0] * sc + u0[k] * skip) * x0[k];
      float v10 = (yy[1] * sc + u1[k] * skip) * x1[k];
      float v01 = (yy[2] * sc + u0[k + 1] * skip) * x0[k + 1];
      float v11 = (yy[3] * sc + u1[k + 1] * skip) * x1[k + 1];
      if (which == 1) {
        v00 *= silu_f(g0[k]); v10 *= silu_f(g1[k]); v01 *= silu_f(g0[k + 1]); v11 *= silu_f(g1[k + 1]);
      }
      *(f32x4*)(sm + n0 + k) = f32x4{v00, v10, v01, v11};
    }
  }
  __syncthreads();
#pragma unroll 2
  for (int i = 0; i < 4; ++i) {
    const int n0 = tid * 8 + 2048 * i;
    u32x4 o0, o1;
#pragma unroll
    for (int k = 0; k < 8; k += 2) {
      f32x4 v = *(const f32x4*)(sm + n0 + k);
      o0[k >> 1] = pack2(v[0], v[2]);
      o1[k >> 1] = pack2(v[1], v[3]);
    }
    *(u32x4*)(urow + n0) = o0;
    *(u32x4*)(urow + 8192 + n0) = o1;
  }
}

__device__ __forceinline__ void job_ctxconv(const Params& p, int layer, int c, int bl, int which, char* smem) {
  float* us = (float*)smem;
  float* h0 = us + 256;
  float* h1 = h0 + 256;
  const int t = get_tid();
  bf16_t* HT = (bf16_t*)(p.ws + OFF_HT);
  const float* cw = p.hy_conv_w + layer * 3 * 1536;
  const float* cb = p.hy_conv_b + layer * 1536;
  const int cx = (which == 0) ? 512 + c : 1024 + c;
  const float skip = p.hy_skip[layer * 1024 + which * 512 + c];
  const int cbase = 16384 + bl * 256;
  bf16_t* urow = HT + (size_t)c * T2 + cbase;
  const bf16_t* xrow = HT + (size_t)cx * T2 + cbase;
  const bf16_t* zrow = HT + (size_t)(1536 + c) * T2 + cbase;
  float u;
  if (which == 0)
    u = ht_conv(urow, t, 256, cw[c], cw[1536 + c], cw[3072 + c], cb[c]);
  else
    u = bf2f(urow[t]);
  const int col0 = which * 512 + c, col1 = 1024 + which * 512 + c;
  const float* HTc = (const float*)(p.ws + OFF_HTC);
  const float* psc = (const float*)(p.ws + OFF_PSUMC);
  float S = 0.f;
#pragma unroll
  for (int lb = 0; lb < 4; ++lb) S += psc[lb * 2048 + col0] + psc[lb * 2048 + col1];
  float* kk = h0;
  __syncthreads();
  us[t] = u;
  kk[255 + t] = HTc[(size_t)col0 * 256 + t];
  if (t >= 1) kk[255 - t] = HTc[(size_t)col1 * 256 + t];
  if (t == 0) kk[511] = 0.f;
  __syncthreads();
  float acc = 0.f;
  const float* kp = kk + 255 + t;
#pragma unroll 4
  for (int s4 = 0; s4 < 256; s4 += 4) {
    const f32x4 u4 = *(const f32x4*)(us + s4);
    acc += kp[-s4] * u4[0] + kp[-s4 - 1] * u4[1] + kp[-s4 - 2] * u4[2] + kp[-s4 - 3] * u4[3];
  }
  float yv = acc / S;
  float xg = ht_conv(xrow, t, 256, cw[cx], cw[1536 + cx], cw[3072 + cx], cb[cx]);
  float v = (yv + u * skip) * xg;
  if (which == 1) v *= silu_f(bf2f(zrow[t]));
  urow[t] = f2bf(v);
}

__device__ __forceinline__ void job_modnorm(const Params& p, int layer, int pass, int j) {
  const int tid_ = get_tid(), lane = tid_ & 63, wave = tid_ >> 6;
  const int r = j * 4 + wave;
  const float* xr;
  int v;
  if (r < 16384) {
    const int b = 2 * pass + (r >> 13), t = r & 8191;
    xr = (layer == 0 ? p.x : p.out) + ((size_t)b * 8192 + t) * 1024;
    v = b;
  } else {
    const int q = r - 16384;
    const int b = 2 * pass + (q >> 8), t = q & 255;
    xr = (layer == 0 ? p.ctx : (const float*)(p.ws + OFF_XCTX)) + ((size_t)b * 256 + t) * 1024;
    v = 4;
  }
  const float* mod = (const float*)(p.ws + OFF_MODS) + (layer * 5 + v) * 3072;
  const float* g = p.norm_g + layer * 1024;
  f32x4 xv[4];
  float ss = 0.f;
#pragma unroll
  for (int i = 0; i < 4; ++i) {
    xv[i] = *(const f32x4*)(xr + lane * 4 + 256 * i);
    ss += xv[i][0] * xv[i][0] + xv[i][1] * xv[i][1] + xv[i][2] * xv[i][2] + xv[i][3] * xv[i][3];
  }
  ss = wave_sum(ss);
  const float rstd = rsqrtf(ss * (1.0f / 1024.0f) + 1e-6f);
  bf16_t* hn = (bf16_t*)(p.ws + OFF_HN) + (size_t)r * 1024;
#pragma unroll
  for (int i = 0; i < 4; ++i) {
    const int col = lane * 4 + 256 * i;
    float4 gg = *(const float4*)(g + col);
    float4 sh = *(const float4*)(mod + col);
    float4 scl = *(const float4*)(mod + 1024 + col);
    f32x4 o;
    o[0] = xv[i][0] * rstd * gg.x * (1.f + scl.x) + sh.x;
    o[1] = xv[i][1] * rstd * gg.y * (1.f + scl.y) + sh.y;
    o[2] = xv[i][2] * rstd * gg.z * (1.f + scl.z) + sh.z;
    o[3] = xv[i][3] * rstd * gg.w * (1.f + scl.w) + sh.w;
    store_bf4(hn + col, o);
  }
}

__device__ __forceinline__ void job_mlanorm(const Params& p, int layer, int j) {
  const int tid_ = get_tid(), lane = tid_ & 63, wave = tid_ >> 6;
  const int r0 = j * 16 + wave * 4;
  bf16_t* row0 = (bf16_t*)(p.ws + OFF_PA2) + (size_t)r0 * 1184;
  const float* gq = p.mla_q_norm + layer * 384;
  const float* gkv = p.mla_kv_norm + layer * 256;
  unsigned u[4][3];
  u32x2 w[4];
  unsigned short k1[4], k2[4];
#pragma unroll
  for (int q = 0; q < 4; ++q) {
    const bf16_t* row = row0 + q * 1184;
#pragma unroll
    for (int i = 0; i < 3; ++i) u[q][i] = *(const unsigned*)(row + lane * 2 + 128 * i);
    w[q] = *(const u32x2*)(row + 384 + lane * 4);
    k1[q] = row[640 + (lane & 15)];
    k2[q] = row[656 + (lane & 15)];
  }
  float gqv[6], gkvv[4];
#pragma unroll
  for (int i = 0; i < 3; ++i) { gqv[2 * i] = gq[lane * 2 + 128 * i]; gqv[2 * i + 1] = gq[lane * 2 + 128 * i + 1]; }
#pragma unroll
  for (int i = 0; i < 4; ++i) gkvv[i] = gkv[lane * 4 + i];
#pragma unroll
  for (int q = 0; q < 4; ++q) {
    const int r = r0 + q;
    bf16_t* row = row0 + q * 1184;
    float ss = 0.f;
#pragma unroll
    for (int i = 0; i < 3; ++i) { float a = lo2f(u[q][i]), b = hi2f(u[q][i]); ss += a * a + b * b; }
    ss = wave_sum(ss);
    const float rstd = rsqrtf(ss * (1.0f / 384.0f) + 1e-6f);
#pragma unroll
    for (int i = 0; i < 3; ++i)
      *(unsigned*)(row + lane * 2 + 128 * i) = pack2(lo2f(u[q][i]) * rstd * gqv[2 * i], hi2f(u[q][i]) * rstd * gqv[2 * i + 1]);
    const float a0 = lo2f(w[q][0]), a1 = hi2f(w[q][0]), a2 = lo2f(w[q][1]), a3 = hi2f(w[q][1]);
    const float ss2 = wave_sum(a0 * a0 + a1 * a1 + a2 * a2 + a3 * a3);
    const float rstd2 = rsqrtf(ss2 * (1.0f / 256.0f) + 1e-6f);
    u32x2 o;
    o[0] = pack2(a0 * rstd2 * gkvv[0], a1 * rstd2 * gkvv[1]);
    o[1] = pack2(a2 * rstd2 * gkvv[2], a3 * rstd2 * gkvv[3]);
    *(u32x2*)(row + 384 + lane * 4) = o;
    if (lane < 16) {
      const float x1 = bf2f(k1[q]), x2 = bf2f(k2[q]);
      float o1 = x1, o2 = x2;
      if (r < 16384) {
        const int t = r & 8191;
        const float2 cssn = ((const float2*)(p.ws + OFF_ROPE))[t * 16 + lane];
        o1 = x1 * cssn.x - x2 * cssn.y;
        o2 = x1 * cssn.y + x2 * cssn.x;
      }
      bf16_t* kf = (bf16_t*)(p.ws + OFF_KF) + (size_t)r * 768;
      const bf16_t b1 = f2bf(o1), b2 = f2bf(o2);
#pragma unroll
      for (int h = 0; h < 8; ++h) {
        kf[h * 96 + 64 + lane] = b1;
        kf[h * 96 + 80 + lane] = b2;
      }
    }
  }
}

__device__ __forceinline__ void job_shortconv(const Params& p, int layer, int j) {
  const int tid = get_tid();
  const bf16_t* PA1 = (const bf16_t*)(p.ws + OFF_PA1);
  bf16_t* AA = (bf16_t*)(p.ws + OFF_AA);
  const float* cw = p.sc_conv_w + layer * 3 * 512;
  const float* cb = p.sc_conv_b + layer * 512;
  const int ch = (tid & 63) * 8;
  for (int it = 0; it < 4; ++it) {
    const int r = j * 16 + it * 4 + (tid >> 6);
    int t, Ls;
    if (r < 16384) { t = r & 8191; Ls = 8192; } else { t = (r - 16384) & 255; Ls = 256; }
    const bf16_t* row = PA1 + (size_t)r * 2048;
    uint4 x0 = *(const uint4*)(row + ch), g0 = *(const uint4*)(row + 1024 + ch);
    uint4 gb = *(const uint4*)(row + 512 + ch), za = *(const uint4*)(row + 1536 + ch);
    uint4 xm = make_uint4(0, 0, 0, 0), gm = xm, xp = xm, gp = xm;
    if (t > 0) { xm = *(const uint4*)(row - 2048 + ch); gm = *(const uint4*)(row - 2048 + 1024 + ch); }
    if (t < Ls - 1) { xp = *(const uint4*)(row + 2048 + ch); gp = *(const uint4*)(row + 2048 + 1024 + ch); }
    const unsigned* x0p = (const unsigned*)&x0; const unsigned* g0p = (const unsigned*)&g0;
    const unsigned* xmp = (const unsigned*)&xm; const unsigned* gmp = (const unsigned*)&gm;
    const unsigned* xpp = (const unsigned*)&xp; const unsigned* gpp = (const unsigned*)&gp;
    const unsigned* gbp = (const unsigned*)&gb; const unsigned* zap = (const unsigned*)&za;
    uint4 o;
    unsigned* op = (unsigned*)&o;
#pragma unroll
    for (int e = 0; e < 4; ++e) {
      const int c0 = ch + 2 * e;
      float r0, r1;
      {
        float pm = lo2f(xmp[e]) * lo2f(gmp[e]), p0 = lo2f(x0p[e]) * lo2f(g0p[e]), pp = lo2f(xpp[e]) * lo2f(gpp[e]);
        float cv = cw[c0] * pm + cw[512 + c0] * p0 + cw[1024 + c0] * pp + cb[c0];
        r0 = silu_f(lo2f(zap[e])) * lo2f(gbp[e]) * cv;
      }
      {
        float pm = hi2f(xmp[e]) * hi2f(gmp[e]), p0 = hi2f(x0p[e]) * hi2f(g0p[e]), pp = hi2f(xpp[e]) * hi2f(gpp[e]);
        float cv = cw[c0 + 1] * pm + cw[512 + c0 + 1] * p0 + cw[1024 + c0 + 1] * pp + cb[c0 + 1];
        r1 = silu_f(hi2f(zap[e])) * hi2f(gbp[e]) * cv;
      }
      op[e] = pack2(r0, r1);
    }
    *(uint4*)(AA + (size_t)r * 512 + ch) = o;
  }
}

__device__ __forceinline__ void job_attn(const Params& p, int bl, int h, int qb, bool isctx, char* smem) {
  const int tid = get_tid512(), lane = tid & 63, wave = tid >> 6, c = lane & 15, g = lane >> 4;
  const bf16_t* Q = (const bf16_t*)(p.ws + OFF_Q);
  const bf16_t* KF = (const bf16_t*)(p.ws + OFF_KF);
  const bf16_t* VT = (const bf16_t*)(p.ws + OFF_VT);
  const bf16_t* PA2 = (const bf16_t*)(p.ws + OFF_PA2);
  bf16_t* AM = (bf16_t*)(p.ws + OFF_AM);
  const int qr0 = isctx ? 16384 + bl * 256 : bl * 8192 + qb * 256;
  bf16_t* Qs = (bf16_t*)smem;
  const float qscale = 0.10206207261596577f * 1.4426950408889634f;
  __syncthreads();
  for (int u = tid; u < 2560; u += 512) {
    const int row = u / 10, k = u % 10;
    const bf16_t* src = Q + (size_t)(qr0 + row) * 768 + h * 96;
    bf16_t* dst = Qs + row * 104;
    if (k < 8) {
      u32x4 v = *(const u32x4*)(src + k * 8);
#pragma unroll
      for (int e = 0; e < 4; ++e) v[e] = pack2(lo2f(v[e]) * qscale, hi2f(v[e]) * qscale);
      *(u32x4*)(dst + k * 8) = v;
    } else {
      const int jh = k - 8;
      const u32x4 a1 = *(const u32x4*)(src + 64 + jh * 8), a2 = *(const u32x4*)(src + 80 + jh * 8);
      const int t = qb * 256 + row;
      const f32x4* rp = (const f32x4*)(p.ws + OFF_ROPE) + (size_t)(isctx ? 0 : t) * 8 + jh * 4;
      u32x4 r1, r2;
#pragma unroll
      for (int e2 = 0; e2 < 4; ++e2) {
        float xa0 = lo2f(a1[e2]), xa1 = hi2f(a1[e2]), xb0 = lo2f(a2[e2]), xb1 = hi2f(a2[e2]);
        float oa0 = xa0, oa1 = xa1, ob0 = xb0, ob1 = xb1;
        if (!isctx) {
          const f32x4 cs2 = rp[e2];
          oa0 = xa0 * cs2[0] - xb0 * cs2[1];
          ob0 = xa0 * cs2[1] + xb0 * cs2[0];
          oa1 = xa1 * cs2[2] - xb1 * cs2[3];
          ob1 = xa1 * cs2[3] + xb1 * cs2[2];
        }
        r1[e2] = pack2(oa0 * qscale, oa1 * qscale);
        r2[e2] = pack2(ob0 * qscale, ob1 * qscale);
      }
      *(u32x4*)(dst + 64 + jh * 8) = r1;
      *(u32x4*)(dst + 80 + jh * 8) = r2;
    }
  }
  __syncthreads();
  bf16x8 bq[2][3];
#pragma unroll
  for (int qs = 0; qs < 2; ++qs)
#pragma unroll
    for (int ks = 0; ks < 3; ++ks) bq[qs][ks] = *(const bf16x8*)(Qs + (wave * 32 + qs * 16 + c) * 104 + ks * 32 + g * 8);
  __syncthreads();

  bf16_t* Ks0 = (bf16_t*)smem;
  bf16_t* Vs0 = (bf16_t*)(smem + 2 * 26624);
  const int nt = isctx ? 2 : 66;
  const int ctxbase = 16384 + bl * 256, latbase = bl * 8192;
  u32x4 rk0, rk1, rk2, rv0, rv1;
  const int kr0 = tid / 12, kc0 = tid % 12, kr1 = (tid + 512) / 12, kc1 = (tid + 512) % 12, kr2 = (tid + 1024) / 12,
            kc2 = (tid + 1024) % 12;
  const int vr0 = tid >> 4, vc0 = tid & 15;
#define ATT_GLOAD(it_)                                                                        \
  {                                                                                           \
    const int kb_ = ((it_) < 2) ? ctxbase + (it_) * 128 : latbase + ((it_) - 2) * 128;       \
    rk0 = *(const u32x4*)(KF + (size_t)(kb_ + kr0) * 768 + h * 96 + kc0 * 8);                \
    rk1 = *(const u32x4*)(KF + (size_t)(kb_ + kr1) * 768 + h * 96 + kc1 * 8);                \
    rk2 = *(const u32x4*)(KF + (size_t)(kb_ + kr2) * 768 + h * 96 + kc2 * 8);                \
    rv0 = *(const u32x4*)(VT + (size_t)(h * 64 + vr0) * T2 + kb_ + vc0 * 8);                  \
    rv1 = *(const u32x4*)(VT + (size_t)(h * 64 + vr0 + 32) * T2 + kb_ + vc0 * 8);             \
  }
#define ATT_LSTORE(buf_)                                                  \
  {                                                                       \
    bf16_t* Ks_ = Ks0 + (buf_) * 13312;                                   \
    bf16_t* Vs_ = Vs0 + (buf_) * 8704;                                    \
    *(u32x4*)(Ks_ + kr0 * 104 + kc0 * 8) = rk0;                           \
    *(u32x4*)(Ks_ + kr1 * 104 + kc1 * 8) = rk1;                           \
    *(u32x4*)(Ks_ + kr2 * 104 + kc2 * 8) = rk2;                           \
    *(u32x4*)(Vs_ + vr0 * 136 + vc0 * 8) = rv0;                           \
    *(u32x4*)(Vs_ + (vr0 + 32) * 136 + vc0 * 8) = rv1;                    \
  }
  f32x4 o[5][2];
#pragma unroll
  for (int ns = 0; ns < 5; ++ns)
#pragma unroll
    for (int qs = 0; qs < 2; ++qs) o[ns][qs] = f32x4{0.f, 0.f, 0.f, 0.f};
  const unsigned onesw = (c == 0) ? 0x3F803F80u : 0u;
  const bf16x8 vones = __builtin_bit_cast(bf16x8, u32x4{onesw, onesw, onesw, onesw});
  f32x4 negm[2] = {f32x4{0.f, 0.f, 0.f, 0.f}, f32x4{0.f, 0.f, 0.f, 0.f}};
#define MAX3(a_, b_, c_) __builtin_fmaxf(__builtin_fmaxf((a_), (b_)), (c_))
  ATT_GLOAD(0);
  ATT_LSTORE(0);
  __syncthreads();
  for (int it = 0; it < nt; ++it) {
    const int buf = it & 1;
    {
      const int itn = (it + 1 < nt) ? it + 1 : it;
      ATT_GLOAD(itn);
    }
    const bf16_t* Ks = Ks0 + buf * 13312;
    const bf16_t* Vs = Vs0 + buf * 8704;
    f32x4 s[8][2];
#pragma unroll
    for (int ks = 0; ks < 3; ++ks)
#pragma unroll
      for (int kt = 0; kt < 8; ++kt) {
        bf16x8 kf = *(const bf16x8*)(Ks + (kt * 16 + c) * 104 + ks * 32 + g * 8);
#pragma unroll
        for (int qs = 0; qs < 2; ++qs)
          s[kt][qs] = __builtin_amdgcn_mfma_f32_16x16x32_bf16(kf, bq[qs][ks], (ks == 0) ? negm[qs] : s[kt][qs], 0, 0, 0);
      }
    bf16x8 pb[4][2];
#pragma unroll
    for (int qs = 0; qs < 2; ++qs) {
      float mx;
      {
        float m8[8];
#pragma unroll
        for (int kt = 0; kt < 8; ++kt) m8[kt] = MAX3(s[kt][qs][0], s[kt][qs][1], __builtin_fmaxf(s[kt][qs][2], s[kt][qs][3]));
        const float ma = MAX3(m8[0], m8[1], m8[2]), mb = MAX3(m8[3], m8[4], m8[5]);
        mx = MAX3(ma, mb, __builtin_fmaxf(m8[6], m8[7]));
        const u32x2 r32_ = __builtin_amdgcn_permlane32_swap(__float_as_uint(mx), __float_as_uint(mx), false, false);
        mx = __builtin_fmaxf(__uint_as_float(r32_[0]), __uint_as_float(r32_[1]));
        const u32x2 r16_ = __builtin_amdgcn_permlane16_swap(__float_as_uint(mx), __float_as_uint(mx), false, false);
        mx = __builtin_fmaxf(__uint_as_float(r16_[0]), __uint_as_float(r16_[1]));
      }
      if (__ballot(mx > 8.0f) != 0ull) {
        const float delta = (mx > 8.0f) ? mx : 0.f;
        const float alpha = __builtin_amdgcn_exp2f(-delta);
#pragma unroll
        for (int kt = 0; kt < 8; ++kt) s[kt][qs] -= delta;
#pragma unroll
        for (int ns = 0; ns < 5; ++ns) o[ns][qs] *= alpha;
        negm[qs] -= delta;
      }
#pragma unroll
      for (int kt = 0; kt < 8; ++kt)
#pragma unroll
        for (int e = 0; e < 4; ++e) s[kt][qs][e] = __builtin_amdgcn_exp2f(s[kt][qs][e]);
#pragma unroll
      for (int i = 0; i < 4; ++i) {
        u32x4 t;
        t[0] = pack2(s[2 * i][qs][0], s[2 * i][qs][1]);
        t[1] = pack2(s[2 * i][qs][2], s[2 * i][qs][3]);
        t[2] = pack2(s[2 * i + 1][qs][0], s[2 * i + 1][qs][1]);
        t[3] = pack2(s[2 * i + 1][qs][2], s[2 * i + 1][qs][3]);
        pb[i][qs] = __builtin_bit_cast(bf16x8, t);
      }
    }
#pragma unroll
    for (int i = 0; i < 4; ++i) {
#pragma unroll
      for (int ns = 0; ns < 4; ++ns) {
        bf16x4 va = *(const bf16x4*)(Vs + (ns * 16 + c) * 136 + (2 * i) * 16 + g * 4);
        bf16x4 vb = *(const bf16x4*)(Vs + (ns * 16 + c) * 136 + (2 * i + 1) * 16 + g * 4);
        bf16x8 vf;
        vf[0] = va[0]; vf[1] = va[1]; vf[2] = va[2]; vf[3] = va[3];
        vf[4] = vb[0]; vf[5] = vb[1]; vf[6] = vb[2]; vf[7] = vb[3];
#pragma unroll
        for (int qs = 0; qs < 2; ++qs) o[ns][qs] = __builtin_amdgcn_mfma_f32_16x16x32_bf16(vf, pb[i][qs], o[ns][qs], 0, 0, 0);
      }
#pragma unroll
      for (int qs = 0; qs < 2; ++qs) o[4][qs] = __builtin_amdgcn_mfma_f32_16x16x32_bf16(vones, pb[i][qs], o[4][qs], 0, 0, 0);
    }
    ATT_LSTORE(buf ^ 1);
    __syncthreads();
  }
#undef MAX3
#pragma unroll
  for (int qs = 0; qs < 2; ++qs) {
    const float l = __shfl(o[4][qs][0], c);
    const float inv = 1.0f / l;
    const int r = qr0 + wave * 32 + qs * 16 + c;
#pragma unroll
    for (int ns = 0; ns < 4; ++ns) {
      const int col = h * 64 + ns * 16 + g * 4;
      u32x2 zz = *(const u32x2*)(PA2 + (size_t)r * 1184 + 672 + col);
      f32x4 v;
      v[0] = o[ns][qs][0] * inv * silu_f(lo2f(zz[0]));
      v[1] = o[ns][qs][1] * inv * silu_f(hi2f(zz[0]));
      v[2] = o[ns][qs][2] * inv * silu_f(lo2f(zz[1]));
      v[3] = o[ns][qs][3] * inv * silu_f(hi2f(zz[1]));
      store_bf4(AM + (size_t)r * 512 + col, v);
    }
  }
}

__device__ __forceinline__ void job_tr_ah(const Params& p, int j, char* smem) {
  bf16_t* ts = (bf16_t*)smem;
  const int tid = get_tid(), a = tid & 63, b4 = tid >> 6;
  const int ct = j & 7, tt = j >> 3;
  const bf16_t* HT = (const bf16_t*)(p.ws + OFF_HT);
  bf16_t* AH = (bf16_t*)(p.ws + OFF_PA1 + 34603008);
  __syncthreads();
#pragma unroll 4
  for (int i = 0; i < 16; ++i) {
    const int ch = i * 4 + b4;
    ts[ch * 66 + a] = HT[(size_t)(ct * 64 + ch) * T2 + tt * 64 + a];
  }
  __syncthreads();
#pragma unroll 4
  for (int i = 0; i < 16; ++i) {
    const int tok = i * 4 + b4;
    AH[(size_t)(tt * 64 + tok) * 512 + ct * 64 + a] = ts[a * 66 + tok];
  }
}

#define XB_TMO 128
#define XB_XCNT(j) (256 + 64 * (j))
#define XB_XSUB(j) (1280 + 64 * (j))
#define XB_XGEN(j) (2304 + 64 * (j))
#define XB_TOP 3328
#define XB_TOPGEN 3392
#define XCD_BAR_WORDS 3456
#define XB_SPIN_CAP (1u << 22)
__device__ __forceinline__ unsigned xb_ld(unsigned* p) { return __hip_atomic_load(p, __ATOMIC_RELAXED, __HIP_MEMORY_SCOPE_AGENT); }
__device__ __forceinline__ unsigned xb_add(unsigned* p, unsigned v) { return __hip_atomic_fetch_add(p, v, __ATOMIC_RELAXED, __HIP_MEMORY_SCOPE_AGENT); }
__device__ __forceinline__ unsigned xb_xcc_id() { return (unsigned)__builtin_amdgcn_s_getreg((3 << 11) | 20) & 0xFu; }
#define XB_SPIN(cond, bar)                                              \
  do {                                                                  \
    unsigned _sp = 0;                                                   \
    while (cond) {                                                      \
      __builtin_amdgcn_s_sleep(1);                                      \
      if ((++_sp & 255u) == 0u) {                                       \
        if (xb_ld(&(bar)[XB_TMO])) break;                               \
        if (_sp > XB_SPIN_CAP) { atomicAdd(&(bar)[XB_TMO], 1u); break; } \
      }                                                                 \
    }                                                                   \
  } while (0)

__device__ __forceinline__ void xb_census(unsigned* bar, unsigned x, unsigned& nloc, unsigned& nx) {
  unsigned cnt = 0u, mine = 0u;
#pragma unroll
  for (unsigned j = 0; j < 16; ++j) {
    const unsigned c = xb_ld(&bar[XB_XCNT(j)]);
    cnt += (c > 0u) ? 1u : 0u;
    mine = (j == x) ? c : mine;
  }
  nloc = mine > 0u ? mine : 1u;
  nx = cnt > 0u ? cnt : 1u;
}

__device__ __forceinline__ void xcd_barrier(unsigned* bar, unsigned x, unsigned nloc, unsigned nx) {
  asm volatile("s_waitcnt vmcnt(0)" ::: "memory");
  __syncthreads();
  if (threadIdx.x == 0) {
    __builtin_amdgcn_s_waitcnt(0);
    const unsigned old = xb_add(&bar[XB_XSUB(x)], 1u);
    const unsigned gen = old / nloc;
    if (old + 1u == (gen + 1u) * nloc) {
      __builtin_amdgcn_fence(__ATOMIC_RELEASE, "agent");
      asm volatile("s_waitcnt vmcnt(0)" ::: "memory");
      const unsigned og = xb_add(&bar[XB_TOP], 1u);
      const unsigned tg = og / nx;
      if (og + 1u == (tg + 1u) * nx) xb_add(&bar[XB_TOPGEN], 1u);
      else XB_SPIN(xb_ld(&bar[XB_TOPGEN]) == tg, bar);
      __builtin_amdgcn_fence(__ATOMIC_ACQUIRE, "agent");
      xb_add(&bar[XB_XGEN(x)], 1u);
      asm volatile("s_waitcnt vmcnt(0)" ::: "memory");
    } else {
      XB_SPIN(xb_ld(&bar[XB_XGEN(x)]) == gen, bar);
      __builtin_amdgcn_fence(__ATOMIC_ACQUIRE, "agent");
      asm volatile("s_waitcnt vmcnt(0)" ::: "memory");
    }
  }
  __syncthreads();
}

__global__ void __launch_bounds__(512, 2) mega(Params p0) {
  cg::grid_group grid = cg::this_grid();
  __shared__ __attribute__((aligned(16))) char smem_dyn[131072];
  const int half = __builtin_amdgcn_readfirstlane((int)(threadIdx.x >> 8));
  char* const smem = smem_dyn + half * 65536;
  const int nph = 1 + 4 * NPH_LAYER + 1;
  const int G = gridDim.x;
  unsigned* const xbar = (unsigned*)(p0.ws + OFF_BAR);
  const unsigned xcc = xb_xcc_id();
  if (threadIdx.x == 0) ((volatile unsigned*)smem_dyn)[0] = xb_add(&xbar[XB_XCNT(xcc)], 1u);
  __syncthreads();
  const unsigned xrank = (unsigned)__builtin_amdgcn_readfirstlane((int)((volatile unsigned*)smem_dyn)[0]);
  __syncthreads();
  unsigned xb_nloc = 1u, xb_nx = 1u;
  int VB = blockIdx.x;
  bool second_half = false;

  for (int ph = 0; ph < nph; ++ph) {
    Params p = p0;
    {
      char* w = p0.ws;
      asm volatile("" : "+s"(w));
      p.ws = w;
    }
    int B = (ph == 0) ? (int)blockIdx.x : VB;
    asm volatile("" : "+s"(B));
    bf16_t* const WIN = (bf16_t*)(p.ws + OFF_WIN);
    bf16_t* const HN = (bf16_t*)(p.ws + OFF_HN);
    bf16_t* const PA1 = (bf16_t*)(p.ws + OFF_PA1);
    bf16_t* const PA2 = (bf16_t*)(p.ws + OFF_PA2);
    bf16_t* const HT = (bf16_t*)(p.ws + OFF_HT);
    if (ph == 0) {
      for (int j = 2 * B + half; j < 192 + 8448 + 64 + 512; j += 2 * G) {
        if (j < 192) job_mods(p, j, smem);
        else if (j < 192 + 8448) job_hid(p, j - 192, smem);
        else if (j < 192 + 8448 + 64) job_tw(p, j - 192 - 8448);
        else job_rope(p, j - 192 - 8448 - 64);
      }
    } else if (ph == nph - 1) {
      for (int j = 2 * B + half; j < 8192; j += 2 * G) {
        const int tid_ = get_tid(), lane = tid_ & 63, wave = tid_ >> 6;
        float* xr = p.out + (size_t)(j * 4 + wave) * 1024;
        f32x4 xv[4];
        float ss = 0.f;
#pragma unroll
        for (int i = 0; i < 4; ++i) {
          xv[i] = *(const f32x4*)(xr + lane * 4 + 256 * i);
          ss += xv[i][0] * xv[i][0] + xv[i][1] * xv[i][1] + xv[i][2] * xv[i][2] + xv[i][3] * xv[i][3];
        }
        ss = wave_sum(ss);
        const float rstd = rsqrtf(ss * (1.0f / 1024.0f) + 1e-6f);
#pragma unroll
        for (int i = 0; i < 4; ++i) {
          const int col = lane * 4 + 256 * i;
          float4 gg = *(const float4*)(p.final_g + col);
          float4 o = make_float4(xv[i][0] * rstd * gg.x, xv[i][1] * rstd * gg.y, xv[i][2] * rstd * gg.z, xv[i][3] * rstd * gg.w);
          *(float4*)(xr + col) = o;
        }
      }
    } else {
      const int q = ph - 1, layer = q / NPH_LAYER, r = q % NPH_LAYER;
      if (r == 0) {
        for (int j = 2 * B + half; j < 2872 + 1056; j += 2 * G) {
          if (j < 2096) {
            const int nt = j / 16, kt = j % 16;
            int nv = 8352 - nt * 64; nv = nv > 64 ? 64 : nv;
            tr_tile(p.w_in + (size_t)layer * 1024 * 8352 + nt * 64, 8352, nv, kt * 64, WIN + (size_t)nt * 64 * 1024, 1024, smem);
          } else if (j < 2096 + 384) {
            const int jj = j - 2096, which = jj / 128, q2 = jj % 128, nt = q2 / 8, kt = q2 % 8;
            const float* src = (which == 0 ? p.sc_out : which == 1 ? p.hy_out : p.mla_out) + (size_t)layer * 512 * 1024 + nt * 64;
            bf16_t* dst = (bf16_t*)(p.ws + (which == 0 ? OFF_WSC : which == 1 ? OFF_WHY : OFF_WMLA)) + (size_t)nt * 64 * 512;
            tr_tile(src, 1024, 64, kt * 64, dst, 512, smem);
          } else if (j < 2096 + 384 + 256) {
            const int jj = j - 2480, nt = jj / 16, kt = jj % 16;
            tr_tile(p.w_o + (size_t)layer * 1024 * 1024 + nt * 64, 1024, 64, kt * 64, (bf16_t*)(p.ws + OFF_WO) + (size_t)nt * 64 * 1024, 1024, smem);
          } else if (j < 2736 + 72) {
            const int jj = j - 2736, nt = jj / 6, kt = jj % 6;
            tr_tile(p.mla_w_uq + (size_t)layer * 384 * 768 + nt * 64, 768, 64, kt * 64, (bf16_t*)(p.ws + OFF_WUQ) + (size_t)nt * 64 * 384, 384, smem);
          } else if (j < 2808 + 64) {
            const int jj = j - 2808, nt = jj / 4, kt = jj % 4, hh = nt >> 1, half = nt & 1;
            bf16_t* dst = (bf16_t*)(p.ws + (half ? OFF_WV : OFF_WKN)) + (size_t)hh * 64 * 256;
            tr_tile(p.mla_w_ukv + (size_t)layer * 256 * 1024 + nt * 64, 1024, 64, kt * 64, dst, 256, smem);
          } else {
            job_hgen(p, layer, j - 2872, smem);
          }
        }
      } else {
        const int pass = (r - 1) / 8, sub = (r - 1) % 8;
        if (sub == 0) {
          if (pass == 0)
            for (int j = 2 * B + half; j < 1024; j += 2 * G) job_filtfft(p, j, smem);
          for (int j = 2 * B + half; j < T2 / 4; j += 2 * G) job_modnorm(p, layer, pass, j);
        } else if (sub >= 1 && sub <= 4) {
          const float* bin = p.b_in + layer * 8352;
          const int nF = (sub >= 3) ? 512 : 0;
          const int nC = (sub == 2 || sub == 4) ? 1024 : 0;
          const int whichF = sub - 3, whichC = (sub == 2) ? 0 : 1;
          const int nG = (sub == 1) ? 1716 : (sub == 3) ? 462 : 0;
          const int nA = (sub == 4) ? 528 : 0;
          const int nE = (sub == 2) ? 2112 : 0;
          const bool fft_first = true;
          for (int ord = 0; ord < 2; ++ord) {
            if ((ord == 0) == fft_first) {
              for (int j = 2 * B + half; j < nF; j += 2 * G) job_fftconv(p, layer, j, whichF, smem);
              for (int j = 2 * B + half; j < nC; j += 2 * G) job_ctxconv(p, layer, j >> 1, j & 1, whichC, smem);
            } else {
              for (int j = 2 * B + half; j < nE; j += 2 * G) {
                if (j < 1056) job_mlanorm(p, layer, j);
                else job_shortconv(p, layer, j - 1056);
              }
              for (int j = B; j < nA; j += G) {
                const bool ic = j >= 512;
                const int jj = j - 512;
                job_attn(p, ic ? (jj >> 3) : (j >> 8), ic ? (jj & 7) : ((j >> 5) & 7), ic ? 0 : (j & 31), ic, smem_dyn);
              }
              for (int j = B; j < nG; j += G) {
                if (sub == 1 && j >= 1056) {
                  const int jj = j - 1056;
                  const int m0 = (jj / 10) * 256, n0 = (jj % 10) * 128;
                  f32x4 acc[4][4];
#pragma unroll
                  for (int mi = 0; mi < 4; ++mi)
#pragma unroll
                    for (int ni = 0; ni < 4; ++ni) acc[mi][ni] = f32x4{0.f, 0.f, 0.f, 0.f};
                  gemm_t512<4, 4, 2>(HN, 1024, WIN + (size_t)4096 * 1024, 1024, 1024, m0, n0, 1184, acc, smem_dyn);
                  const int t5 = get_tid512(), l5 = t5 & 63, w5 = t5 >> 6, g5 = l5 >> 4;
#pragma unroll
                  for (int mi = 0; mi < 4; ++mi)
#pragma unroll
                    for (int ni2 = 0; ni2 < 4; ni2 += 2) {
                      const int row = m0 + (w5 >> 1) * 64 + mi * 16 + (l5 & 15);
                      const int colA = n0 + (w5 & 1) * 64 + ni2 * 16 + g5 * 4;
                      const float4 ba = *(const float4*)(bin + 4096 + colA), bb = *(const float4*)(bin + 4096 + colA + 16);
                      f32x4 va = acc[mi][ni2], vb = acc[mi][ni2 + 1];
                      va[0] += ba.x; va[1] += ba.y; va[2] += ba.z; va[3] += ba.w;
                      vb[0] += bb.x; vb[1] += bb.y; vb[2] += bb.z; vb[3] += bb.w;
                      const unsigned x0 = pack2(va[0], va[1]), x1 = pack2(va[2], va[3]);
                      const unsigned y0 = pack2(vb[0], vb[1]), y1 = pack2(vb[2], vb[3]);
                      const u32x2 s0 = __builtin_amdgcn_permlane16_swap(x0, y0, false, false);
                      const u32x2 s1 = __builtin_amdgcn_permlane16_swap(x1, y1, false, false);
                      const int col = n0 + (w5 & 1) * 64 + (ni2 + (g5 & 1)) * 16 + (g5 >> 1) * 8;
                      if (col < 1184) *(u32x4*)(PA2 + (size_t)row * 1184 + col) = u32x4{s0[0], s1[0], s0[1], s1[1]};
                    }
                  continue;
                }
                int kind, m0, n0, lda, ldb, K, nmax;
                const bf16_t *Ap, *Bp;
                if (sub == 1) {
                  if (j < 528) { kind = 0; m0 = (j >> 3) * 256; n0 = (j & 7) * 256; Ap = HN; lda = 1024; Bp = WIN; ldb = 1024; K = 1024; nmax = 2048; }
                  else { const int jj = j - 528; kind = 2; m0 = (jj & 7) * 256; n0 = (jj >> 3) * 256; Ap = WIN + (size_t)2048 * 1024; lda = 1024; Bp = HN; ldb = 1024; K = 1024; nmax = T2; }
                } else {
                  if (j < 198) { kind = 3; m0 = (j / 3) * 256; n0 = (j % 3) * 256; Ap = PA2; lda = 1184; Bp = (const bf16_t*)(p.ws + OFF_WUQ); ldb = 384; K = 384; nmax = 768; }
                  else if (j < 330) { const int j3 = j - 198; kind = 4; m0 = (j3 >> 1) * 256; n0 = (j3 & 1) * 256; Ap = PA2 + 384; lda = 1184; Bp = (const bf16_t*)(p.ws + OFF_WKN); ldb = 256; K = 256; nmax = 512; }
                  else { const int j3 = j - 330; kind = 5; m0 = (j3 & 1) * 256; n0 = (j3 >> 1) * 256; Ap = (const bf16_t*)(p.ws + OFF_WV); lda = 256; Bp = PA2 + 384; ldb = 1184; K = 256; nmax = T2; }
                }
                f32x4 acc[8][4];
#pragma unroll
                for (int mi = 0; mi < 8; ++mi)
#pragma unroll
                  for (int ni = 0; ni < 4; ++ni) acc[mi][ni] = f32x4{0.f, 0.f, 0.f, 0.f};
                gemm_t512<8, 4, 4>(Ap, lda, Bp, ldb, K, m0, n0, nmax, acc, smem_dyn);
                const int t5 = get_tid512(), l5 = t5 & 63, w5 = t5 >> 6, g5 = l5 >> 4;
#pragma unroll
                for (int mi = 0; mi < 8; ++mi)
#pragma unroll
                  for (int ni2 = 0; ni2 < 4; ni2 += 2) {
                    const int row = m0 + (w5 >> 2) * 128 + mi * 16 + (l5 & 15);
                    const int colA = n0 + (w5 & 3) * 64 + ni2 * 16 + g5 * 4;
                    f32x4 va = acc[mi][ni2], vb = acc[mi][ni2 + 1];
                    if (kind == 0) {
                      const float4 ba = *(const float4*)(bin + colA), bb = *(const float4*)(bin + colA + 16);
                      va[0] += ba.x; va[1] += ba.y; va[2] += ba.z; va[3] += ba.w;
                      vb[0] += bb.x; vb[1] += bb.y; vb[2] += bb.z; vb[3] += bb.w;
                    } else if (kind == 2) {
                      const float bsc = bin[2048 + row];
                      va += bsc;
                      vb += bsc;
                    }
                    const unsigned x0 = pack2(va[0], va[1]), x1 = pack2(va[2], va[3]);
                    const unsigned y0 = pack2(vb[0], vb[1]), y1 = pack2(vb[2], vb[3]);
                    const u32x2 s0 = __builtin_amdgcn_permlane16_swap(x0, y0, false, false);
                    const u32x2 s1 = __builtin_amdgcn_permlane16_swap(x1, y1, false, false);
                    const u32x4 o = {s0[0], s1[0], s0[1], s1[1]};
                    const int col = n0 + (w5 & 3) * 64 + (ni2 + (g5 & 1)) * 16 + (g5 >> 1) * 8;
                    bf16_t* dst;
                    if (kind == 0) dst = PA1 + (size_t)row * 2048 + col;
                    else if (kind == 2) dst = HT + (size_t)row * T2 + col;
                    else if (kind == 3) dst = (bf16_t*)(p.ws + OFF_Q) + (size_t)row * 768 + col;
                    else if (kind == 4) dst = (bf16_t*)(p.ws + OFF_KF) + (size_t)row * 768 + (col >> 6) * 96 + (col & 63);
                    else dst = (bf16_t*)(p.ws + OFF_VT) + (size_t)row * T2 + col;
                    *(u32x4*)dst = o;
                  }
              }
            }
          }
        } else if (sub == 5) {
          for (int j = 2 * B + half; j < 2112; j += 2 * G) job_tr_ah(p, j, smem);
        } else if (sub == 6) {
          const float* bin = p.b_in + layer * 8352 + 5280;
          bf16_t* Y = PA1;
          for (int j = B; j < 512; j += G) {
            const int m0 = (j >> 3) * 256, n0 = (j & 7) * 128;
            const int t5 = get_tid512(), l5 = t5 & 63, w5 = t5 >> 6;
            u32x2 yp[4][4];
#pragma unroll
            for (int mi = 0; mi < 4; ++mi)
#pragma unroll
              for (int ni = 0; ni < 4; ++ni) yp[mi][ni] = u32x2{0u, 0u};
            for (int br = 0; br < 3; ++br) {
              const bf16_t* Abr = (const bf16_t*)(p.ws + (br == 0 ? OFF_AA : br == 1 ? OFF_PA1 + 34603008 : OFF_AM));
              const bf16_t* Wbr = (const bf16_t*)(p.ws + (br == 0 ? OFF_WSC : br == 1 ? OFF_WHY : OFF_WMLA));
              u32x2 tp[4][4];
              {
                f32x4 t[4][4];
#pragma unroll
                for (int mi = 0; mi < 4; ++mi)
#pragma unroll
                  for (int ni = 0; ni < 4; ++ni) t[mi][ni] = f32x4{0.f, 0.f, 0.f, 0.f};
                gemm_t512<4, 4, 2>(Abr, 512, Wbr, 512, 512, m0, n0, 1024, t, smem_dyn);
#pragma unroll
                for (int mi = 0; mi < 4; ++mi)
#pragma unroll
                  for (int ni = 0; ni < 4; ++ni) { tp[mi][ni][0] = pack2(t[mi][ni][0], t[mi][ni][1]); tp[mi][ni][1] = pack2(t[mi][ni][2], t[mi][ni][3]); }
              }
              f32x4 ga[4][4];
#pragma unroll
              for (int mi = 0; mi < 4; ++mi)
#pragma unroll
                for (int ni = 0; ni < 4; ++ni) ga[mi][ni] = f32x4{0.f, 0.f, 0.f, 0.f};
              gemm_t512<4, 4, 2>(HN, 1024, WIN + (size_t)(5280 + br * 1024) * 1024, 1024, 1024, m0, n0, 1024, ga, smem_dyn);
#pragma unroll
              for (int mi = 0; mi < 4; ++mi)
#pragma unroll
                for (int ni = 0; ni < 4; ++ni) {
                  const int col = n0 + (w5 & 1) * 64 + ni * 16 + (l5 >> 4) * 4;
                  float4 b = *(const float4*)(bin + br * 1024 + col);
                  const float y0 = lo2f(yp[mi][ni][0]) + sigm_f(ga[mi][ni][0] + b.x) * lo2f(tp[mi][ni][0]);
                  const float y1 = hi2f(yp[mi][ni][0]) + sigm_f(ga[mi][ni][1] + b.y) * hi2f(tp[mi][ni][0]);
                  const float y2 = lo2f(yp[mi][ni][1]) + sigm_f(ga[mi][ni][2] + b.z) * lo2f(tp[mi][ni][1]);
                  const float y3 = hi2f(yp[mi][ni][1]) + sigm_f(ga[mi][ni][3] + b.w) * hi2f(tp[mi][ni][1]);
                  yp[mi][ni][0] = pack2(y0, y1);
                  yp[mi][ni][1] = pack2(y2, y3);
                }
            }
#pragma unroll
            for (int mi = 0; mi < 4; ++mi)
#pragma unroll
              for (int ni2 = 0; ni2 < 4; ni2 += 2) {
                const int g5 = l5 >> 4;
                const int row = m0 + (w5 >> 1) * 64 + mi * 16 + (l5 & 15);
                const u32x2 s0 = __builtin_amdgcn_permlane16_swap(yp[mi][ni2][0], yp[mi][ni2 + 1][0], false, false);
                const u32x2 s1 = __builtin_amdgcn_permlane16_swap(yp[mi][ni2][1], yp[mi][ni2 + 1][1], false, false);
                const int col = n0 + (w5 & 1) * 64 + (ni2 + (g5 & 1)) * 16 + (g5 >> 1) * 8;
                *(u32x4*)(Y + (size_t)row * 1024 + col) = u32x4{s0[0], s1[0], s0[1], s1[1]};
              }
          }
          for (int j = 2048 + 2 * B + half; j < 2112; j += 2 * G) {
            int t132, t16;
            { const int inner = j - 2048; t132 = 128 + (inner & 3); t16 = inner >> 2; }
            const int m0 = t132 * 128, n0 = t16 * 64;
            f32x4 y[4][2];
            zero_acc<2>(y);
            for (int br = 0; br < 3; ++br) {
              const bf16_t* Abr = (const bf16_t*)(p.ws + (br == 0 ? OFF_AA : br == 1 ? OFF_PA1 + 34603008 : OFF_AM));
              const bf16_t* Wbr = (const bf16_t*)(p.ws + (br == 0 ? OFF_WSC : br == 1 ? OFF_WHY : OFF_WMLA));
              f32x4 t[4][2], ga[4][2];
              zero_acc<2>(t);
              zero_acc<2>(ga);
              gemm_main<2>(Abr, 512, Wbr, 512, 512, m0, n0, 1024, t, smem);
              gemm_main<2>(HN, 1024, WIN + (size_t)(5280 + br * 1024) * 1024, 1024, 1024, m0, n0, 1024, ga, smem);
              EPI_LOOP(2) {
                const int col = EPI_COL(2);
                float4 b = *(const float4*)(bin + br * 1024 + col);
                y[mi][ni][0] += sigm_f(ga[mi][ni][0] + b.x) * t[mi][ni][0];
                y[mi][ni][1] += sigm_f(ga[mi][ni][1] + b.y) * t[mi][ni][1];
                y[mi][ni][2] += sigm_f(ga[mi][ni][2] + b.z) * t[mi][ni][2];
                y[mi][ni][3] += sigm_f(ga[mi][ni][3] + b.w) * t[mi][ni][3];
              }
            }
            EPI_LOOP(2) {
              const int row = EPI_ROW, col = EPI_COL(2);
              store_bf4(Y + (size_t)row * 1024 + col, y[mi][ni]);
            }
          }
        } else {
          for (int j = B; j < 256; j += G) {
            const int m0 = (j >> 2) * 256, n0 = (j & 3) * 256;
            const int t5 = get_tid512(), l5 = t5 & 63, w5 = t5 >> 6;
            f32x4 acc[8][4];
#pragma unroll
            for (int mi = 0; mi < 8; ++mi)
#pragma unroll
              for (int ni = 0; ni < 4; ++ni) acc[mi][ni] = f32x4{0.f, 0.f, 0.f, 0.f};
            gemm_t512<8, 4, 4>(PA1, 1024, (const bf16_t*)(p.ws + OFF_WO), 1024, 1024, m0, n0, 1024, acc, smem_dyn);
#pragma unroll
            for (int mi = 0; mi < 8; ++mi)
#pragma unroll
              for (int ni = 0; ni < 4; ++ni) {
                const int row = m0 + (w5 >> 2) * 128 + mi * 16 + (l5 & 15);
                const int col = n0 + (w5 & 3) * 64 + ni * 16 + (l5 >> 4) * 4;
                const int b = 2 * pass + (row >> 13), t = row & 8191;
                const size_t off = ((size_t)b * 8192 + t) * 1024 + col;
                const float* xi = (layer == 0 ? p.x : p.out) + off;
                float* xo = p.out + off;
                const float* gate = (const float*)(p.ws + OFF_MODS) + (layer * 5 + b) * 3072 + 2048 + col;
                float4 gt = *(const float4*)gate;
                float4 xv = *(const float4*)xi;
                float4 o = make_float4(xv.x + gt.x * acc[mi][ni][0], xv.y + gt.y * acc[mi][ni][1], xv.z + gt.z * acc[mi][ni][2],
                                       xv.w + gt.w * acc[mi][ni][3]);
                *(float4*)xo = o;
              }
          }
          for (int j = 2048 + 2 * B + half; j < 2112; j += 2 * G) {
            int t132, t16;
            { const int inner = j - 2048; t132 = 128 + (inner & 3); t16 = inner >> 2; }
            const int m0 = t132 * 128, n0 = t16 * 64;
            f32x4 acc[4][2];
            zero_acc<2>(acc);
            gemm_main<2>(PA1, 1024, (const bf16_t*)(p.ws + OFF_WO), 1024, 1024, m0, n0, 1024, acc, smem);
            EPI_LOOP(2) {
              const int row = EPI_ROW, col = EPI_COL(2);
              const float* xi;
              float* xo;
              int v;
              if (row < 16384) {
                const int b = 2 * pass + (row >> 13), t = row & 8191;
                const size_t off = ((size_t)b * 8192 + t) * 1024 + col;
                xi = (layer == 0 ? p.x : p.out) + off;
                xo = p.out + off;
                v = b;
              } else {
                const int qq = row - 16384;
                const int b = 2 * pass + (qq >> 8), t = qq & 255;
                const size_t off = ((size_t)b * 256 + t) * 1024 + col;
                xi = (layer == 0 ? p.ctx : (const float*)(p.ws + OFF_XCTX)) + off;
                xo = (float*)(p.ws + OFF_XCTX) + off;
                v = 4;
              }
              const float* gate = (const float*)(p.ws + OFF_MODS) + (layer * 5 + v) * 3072 + 2048 + col;
              float4 gt = *(const float4*)gate;
              float4 xv = *(const float4*)xi;
              float4 o = make_float4(xv.x + gt.x * acc[mi][ni][0], xv.y + gt.y * acc[mi][ni][1], xv.z + gt.z * acc[mi][ni][2],
                                     xv.w + gt.w * acc[mi][ni][3]);
              *(float4*)xo = o;
            }
          }
        }
      }
    }
    if (ph == 0) {
      if (p0.ws == nullptr) grid.sync();
      {
        unsigned sp = 0u;
        for (;;) {
          unsigned sum = 0u;
#pragma unroll
          for (unsigned j = 0; j < 16; ++j) sum += xb_ld(&xbar[XB_XCNT(j)]);
          if (sum == (unsigned)G) break;
          __builtin_amdgcn_s_sleep(1);
          if (++sp > XB_SPIN_CAP) break;
        }
      }
      xb_census(xbar, xcc, xb_nloc, xb_nx);
      xb_nloc = (unsigned)__builtin_amdgcn_readfirstlane((int)xb_nloc);
      xb_nx = (unsigned)__builtin_amdgcn_readfirstlane((int)xb_nx);
      {
        unsigned base = 0u;
#pragma unroll
        for (unsigned j = 0; j < 16; ++j) {
          const unsigned cnt = xb_ld(&xbar[XB_XCNT(j)]);
          base += (j < xcc) ? cnt : 0u;
        }
        VB = __builtin_amdgcn_readfirstlane((int)(base + xrank));
        second_half = xrank >= (xb_nloc >> 1);
      }
      xcd_barrier(xbar, xcc, xb_nloc, xb_nx);
    } else if (ph + 1 < nph) {
      xcd_barrier(xbar, xcc, xb_nloc, xb_nx);
    }
  }
}

extern "C" void kernel_launch(void* const* d_in, const int* in_sizes, int n_in, void* d_out, int out_size, void* d_ws,
                              size_t ws_size, hipStream_t stream) {
  constexpr int kDynLds = 0;
  static int grid_blocks = 0;
  if (!grid_blocks) {
    int dev = 0, cus = 0, per_cu = 0;
    hipGetDevice(&dev);
    hipDeviceGetAttribute(&cus, hipDeviceAttributeMultiprocessorCount, dev);
    hipOccupancyMaxActiveBlocksPerMultiprocessor(&per_cu, mega, 512, kDynLds);
    if (per_cu > 1) per_cu = 1;
    if (per_cu < 1) per_cu = 1;
    grid_blocks = cus * per_cu;
  }
  Params p{};
  const float** pp = (const float**)&p;
  for (int i = 0; i < 29; ++i) pp[i] = (const float*)d_in[i];
  p.out = (float*)d_out;
  p.ws = (char*)d_ws;
  if (ws_size < WS_TOTAL) {
    fprintf(stderr, "workspace too small: %zu < %zu\n", ws_size, (size_t)WS_TOTAL);
    return;
  }
  (void)hipMemsetAsync((char*)d_ws + OFF_BAR, 0, 16384, stream);
  void* args[] = {&p};
  hipError_t e = hipLaunchCooperativeKernel((void*)mega, dim3(grid_blocks), dim3(512), args, kDynLds, stream);
  if (e != hipSuccess) fprintf(stderr, "coop launch failed: %s (grid %d)\n", hipGetErrorString(e), grid_blocks);
}
```

```cpp
#include <hip/hip_runtime.h>
#include <hip/hip_cooperative_groups.h>
#include <cstdio>
#include <cstdint>
namespace cg = cooperative_groups;

typedef unsigned short bf16_t;
using bf16x8 = __attribute__((ext_vector_type(8))) short;
using bf16x4 = __attribute__((ext_vector_type(4))) short;
using f32x4 = __attribute__((ext_vector_type(4))) float;
using u32x4 = __attribute__((ext_vector_type(4))) unsigned;
using u32x2 = __attribute__((ext_vector_type(2))) unsigned;
using f32x2 = __attribute__((ext_vector_type(2))) float;
typedef _Float16 h16x2_t __attribute__((ext_vector_type(2)));

constexpr int T2 = 16896;
constexpr int NPH_LAYER = 16;

constexpr size_t OFF_MODS = 0;
constexpr size_t OFF_HID2 = OFF_MODS + 245760;
constexpr size_t OFF_TW = OFF_HID2 + 8650752;
constexpr size_t OFF_XCTX = OFF_TW + 131072;
constexpr size_t OFF_WIN = OFF_XCTX + 4194304;
constexpr size_t OFF_WSC = OFF_WIN + 17104896;
constexpr size_t OFF_WHY = OFF_WSC + 1048576;
constexpr size_t OFF_WMLA = OFF_WHY + 1048576;
constexpr size_t OFF_WO = OFF_WMLA + 1048576;
constexpr size_t OFF_WUQ = OFF_WO + 2097152;
constexpr size_t OFF_WKN = OFF_WUQ + 589824;
constexpr size_t OFF_WV = OFF_WKN + 262144;
constexpr size_t OFF_SPEC = OFF_WV + 262144;
constexpr size_t OFF_HTC = OFF_SPEC + 134217728;
constexpr size_t OFF_PSUM = OFF_HTC + 2097152;
constexpr size_t OFF_PSUMC = OFF_PSUM + 1048576;
constexpr size_t OFF_HN = OFF_PSUMC + 32768;
constexpr size_t OFF_PA1 = OFF_HN + 34603008;
constexpr size_t OFF_PA2 = OFF_PA1 + 69206016;
constexpr size_t OFF_HT = OFF_PA2 + 40009728;
constexpr size_t OFF_Q = OFF_HT + 69206016;
constexpr size_t OFF_KF = OFF_Q + 25952256;
constexpr size_t OFF_VT = OFF_KF + 25952256;
constexpr size_t OFF_AA = OFF_VT + 17301504;
constexpr size_t OFF_AM = OFF_AA + 17301504;
constexpr size_t OFF_BAR = OFF_AM + 17301504;
constexpr size_t OFF_ROPE = OFF_BAR + 16384;
constexpr size_t WS_TOTAL = OFF_ROPE + 1048576;

struct Params {
  const float *x, *c, *ctx, *c_ctx, *ada_w, *ada_b, *norm_g, *w_in, *b_in, *sc_conv_w, *sc_conv_b, *sc_out, *hy_conv_w,
      *hy_conv_b, *hy_w1, *hy_b1, *hy_w2, *hy_b2, *hy_w3, *hy_freq, *hy_skip, *hy_out, *mla_q_norm, *mla_w_uq,
      *mla_kv_norm, *mla_w_ukv, *mla_out, *w_o, *final_g;
  float* out;
  char* ws;
};

typedef __bf16 bf16v2_t __attribute__((ext_vector_type(2)));
__device__ __forceinline__ unsigned pack2(float a, float b) {
  f32x2 v = {a, b};
  bf16v2_t r = __builtin_convertvector(v, bf16v2_t);
  return __builtin_bit_cast(unsigned, r);
}
__device__ __forceinline__ bf16_t f2bf(float f) { return (bf16_t)(pack2(f, 0.f) & 0xffffu); }
__device__ __forceinline__ float bf2f(bf16_t h) { return __uint_as_float(((unsigned)h) << 16); }
__device__ __forceinline__ float lo2f(unsigned u) { return __uint_as_float(u << 16); }
__device__ __forceinline__ float hi2f(unsigned u) { return __uint_as_float(u & 0xffff0000u); }
__device__ __forceinline__ float silu_f(float x) { return x / (1.f + __expf(-x)); }
__device__ __forceinline__ float sigm_f(float x) { return 1.f / (1.f + __expf(-x)); }
__device__ __forceinline__ int get_tid() {
  int t = threadIdx.x & 255;
  asm volatile("" : "+v"(t));
  return t;
}
__device__ __forceinline__ int get_tid512() {
  int t = threadIdx.x;
  asm volatile("" : "+v"(t));
  return t;
}
__device__ __forceinline__ float wave_sum(float v) {
#pragma unroll
  for (int m = 32; m >= 1; m >>= 1) v += __shfl_xor(v, m);
  return v;
}

template <int NI>
__device__ __forceinline__ void gemm_main(const bf16_t* __restrict__ A, int lda, const bf16_t* __restrict__ Bt, int ldb,
                                          int K, int m0, int n0, int nmax, f32x4 (&acc)[4][NI], char* smem) {
  constexpr int STAGE = (128 + 32 * NI) * 64;
  bf16_t* S0 = (bf16_t*)smem;
  const int tid = get_tid(), lane = tid & 63, wave = tid >> 6;
  const int wm = wave >> 1, wn = wave & 1, c = lane & 15, g = lane >> 4;
  const int lrow = tid >> 3, lkc = tid & 7;
  const int wsw = (lkc ^ ((lrow >> 1) & 7)) * 8;
  const int rsw = (c >> 1) & 7;
  u32x4 ra0[4], rb0[NI], ra1[4], rb1[NI];
  const bf16_t* ap = A + (size_t)(m0 + lrow) * lda + lkc * 8;
  const size_t astep = (size_t)32 * lda;
  const bf16_t* bp[NI];
#pragma unroll
  for (int i = 0; i < NI; ++i) {
    int br = n0 + lrow + i * 32;
    br = br < nmax ? br : nmax - 1;
    bp[i] = Bt + (size_t)br * ldb + lkc * 8;
  }
  const int nk = K >> 6;
#define GEMM_GLOAD(RA, RB, KT)                                                            \
  {                                                                                       \
    const int ko_ = ((KT) < nk ? (KT) : nk - 1) * 64;                                     \
    _Pragma("unroll") for (int i = 0; i < 4; ++i) RA[i] = *(const u32x4*)(ap + i * astep + ko_); \
    _Pragma("unroll") for (int i = 0; i < NI; ++i) RB[i] = *(const u32x4*)(bp[i] + ko_);  \
  }
#define GEMM_LSTORE(RA, RB, ST)                                                                            \
  {                                                                                                        \
    bf16_t* As_ = S0 + (ST) * STAGE;                                                                       \
    bf16_t* Bs_ = As_ + 128 * 64;                                                                          \
    _Pragma("unroll") for (int i = 0; i < 4; ++i) *(u32x4*)(As_ + (lrow + i * 32) * 64 + wsw) = RA[i];     \
    _Pragma("unroll") for (int i = 0; i < NI; ++i) *(u32x4*)(Bs_ + (lrow + i * 32) * 64 + wsw) = RB[i];    \
  }
#define GEMM_COMPUTE(ST)                                                                                                 \
  {                                                                                                                      \
    const bf16_t* As = S0 + (ST) * STAGE;                                                                                \
    const bf16_t* Bs = As + 128 * 64;                                                                                    \
    _Pragma("unroll") for (int kk = 0; kk < 2; ++kk) {                                                                   \
      bf16x8 af[4], bfr[NI];                                                                                             \
      const int ch = ((kk * 4 + g) ^ rsw) * 8;                                                                           \
      _Pragma("unroll") for (int mi = 0; mi < 4; ++mi) af[mi] = *(const bf16x8*)(As + (wm * 64 + mi * 16 + c) * 64 + ch); \
      _Pragma("unroll") for (int ni = 0; ni < NI; ++ni) bfr[ni] = *(const bf16x8*)(Bs + (wn * 16 * NI + ni * 16 + c) * 64 + ch); \
      _Pragma("unroll") for (int mi = 0; mi < 4; ++mi) _Pragma("unroll") for (int ni = 0; ni < NI; ++ni)                \
          acc[mi][ni] = __builtin_amdgcn_mfma_f32_16x16x32_bf16(bfr[ni], af[mi], acc[mi][ni], 0, 0, 0);                 \
    }                                                                                                                    \
  }
  GEMM_GLOAD(ra0, rb0, 0);
  GEMM_GLOAD(ra1, rb1, 1);
  __syncthreads();
  GEMM_LSTORE(ra0, rb0, 0);
  GEMM_GLOAD(ra0, rb0, 2);
  __syncthreads();
  for (int kt = 0; kt < nk; kt += 2) {
    GEMM_LSTORE(ra1, rb1, 1);
    GEMM_GLOAD(ra1, rb1, kt + 3);
    __builtin_amdgcn_sched_barrier(0);
    GEMM_COMPUTE(0);
    __syncthreads();
    if (kt + 2 < nk) GEMM_LSTORE(ra0, rb0, 0);
    GEMM_GLOAD(ra0, rb0, kt + 4);
    __builtin_amdgcn_sched_barrier(0);
    GEMM_COMPUTE(1);
    __syncthreads();
  }
#undef GEMM_COMPUTE
#undef GEMM_GLOAD
#undef GEMM_LSTORE
}

template <int NI>
__device__ __forceinline__ void zero_acc(f32x4 (&acc)[4][NI]) {
#pragma unroll
  for (int mi = 0; mi < 4; ++mi)
#pragma unroll
    for (int ni = 0; ni < NI; ++ni) acc[mi][ni] = f32x4{0.f, 0.f, 0.f, 0.f};
}

template <int MI, int NI, int WN>
__device__ __forceinline__ void gemm_t512(const bf16_t* __restrict__ A, int lda, const bf16_t* __restrict__ Bt, int ldb,
                                          int K, int m0, int n0, int nmax, f32x4 (&acc)[MI][NI], char* smem) {
  constexpr int BN = WN * NI * 16;
  constexpr int NB = BN / 64;
  constexpr int STAGE = (256 + BN) * 64;
  typedef __attribute__((address_space(3))) unsigned lds_u32;
  bf16_t* S0 = (bf16_t*)smem;
  const int tid = get_tid512(), lane = tid & 63, wave = tid >> 6;
  const int wm = wave / WN, wn = wave % WN, c = lane & 15, g = lane >> 4;
  const int lrow = tid >> 3, lkc = tid & 7;
  const int skc = (lkc ^ ((lrow >> 1) & 7)) * 8;
  const int rsw = (c >> 1) & 7;
  const bf16_t* ap = A + (size_t)(m0 + lrow) * lda + skc;
  const size_t astep = (size_t)64 * lda;
  int bo[NB];
#pragma unroll
  for (int i = 0; i < NB; ++i) {
    int br = n0 + lrow + i * 64;
    br = br < nmax ? br : nmax - 1;
    bo[i] = br * ldb + skc;
  }
  const int nk = K >> 6;
#define G5_GLDS(ST, KT)                                                                                         \
  {                                                                                                             \
    const int ko_ = (KT) * 64;                                                                                  \
    char* As_ = (char*)(S0 + (ST) * STAGE) + tid * 16;                                                          \
    char* Bs_ = As_ + 256 * 128;                                                                                \
    _Pragma("unroll") for (int i = 0; i < 4; ++i)                                                               \
        __builtin_amdgcn_global_load_lds((const unsigned*)(ap + i * astep + ko_), (lds_u32*)(As_ + i * 8192), 16, 0, 0); \
    _Pragma("unroll") for (int i = 0; i < NB; ++i)                                                              \
        __builtin_amdgcn_global_load_lds((const unsigned*)(Bt + (bo[i] + ko_)), (lds_u32*)(Bs_ + i * 8192), 16, 0, 0);   \
  }
  __syncthreads();
  G5_GLDS(0, 0);
  __syncthreads();
  for (int kt = 0; kt < nk; ++kt) {
    const int st = kt & 1;
    if (kt + 1 < nk) G5_GLDS(st ^ 1, kt + 1);
    const bf16_t* As = S0 + st * STAGE;
    const bf16_t* Bs = As + 256 * 64;
#pragma unroll
    for (int kk = 0; kk < 2; ++kk) {
      bf16x8 bfr[NI];
      const int ch = ((kk * 4 + g) ^ rsw) * 8;
#pragma unroll
      for (int ni = 0; ni < NI; ++ni) bfr[ni] = *(const bf16x8*)(Bs + (wn * NI * 16 + ni * 16 + c) * 64 + ch);
#pragma unroll
      for (int mi = 0; mi < MI; ++mi) {
        const bf16x8 af = *(const bf16x8*)(As + (wm * MI * 16 + mi * 16 + c) * 64 + ch);
#pragma unroll
        for (int ni = 0; ni < NI; ++ni)
          acc[mi][ni] = __builtin_amdgcn_mfma_f32_16x16x32_bf16(bfr[ni], af, acc[mi][ni], 0, 0, 0);
      }
    }
    asm volatile("s_waitcnt vmcnt(0)" ::: "memory");
    __syncthreads();
  }
#undef G5_GLDS
}

#define EPI_LOOP(NI_)                                                                                   \
  const int _tid = get_tid(), _lane = _tid & 63, _wave = _tid >> 6, _wm = _wave >> 1, _wn = _wave & 1;    \
  _Pragma("unroll") for (int mi = 0; mi < 4; ++mi) _Pragma("unroll") for (int ni = 0; ni < NI_; ++ni)

#define EPI_ROW (m0 + _wm * 64 + mi * 16 + (_lane & 15))
#define EPI_COL(NI_) (n0 + _wn * 16 * NI_ + ni * 16 + (_lane >> 4) * 4)

__device__ __forceinline__ void store_bf4(bf16_t* dst, f32x4 v) {
  u32x2 u;
  u[0] = pack2(v[0], v[1]);
  u[1] = pack2(v[2], v[3]);
  *(u32x2*)dst = u;
}

__device__ __forceinline__ void job_mods(const Params& p, int j, char* smem) {
  float* s = (float*)smem;
  float* red = s + 5 * 1024;
  const int layer = j / 48, chunk = j % 48, tid = get_tid();
  __syncthreads();
  for (int i = tid; i < 5 * 1024; i += 256) {
    int v = i >> 10, k = i & 1023;
    float cv = (v < 4) ? p.c[v * 1024 + k] : p.c_ctx[k];
    s[i] = silu_f(cv);
  }
  __syncthreads();
  const int col = tid & 63, kg = tid >> 6;
  const int n = chunk * 64 + col;
  const float* w = p.ada_w + (size_t)layer * 1024 * 3072 + (size_t)(kg * 256) * 3072 + n;
  float a0 = 0, a1 = 0, a2 = 0, a3 = 0, a4 = 0;
#pragma unroll 8
  for (int k = 0; k < 256; ++k) {
    float wv = w[(size_t)k * 3072];
    const int kk = kg * 256 + k;
    a0 += s[kk] * wv;
    a1 += s[1024 + kk] * wv;
    a2 += s[2048 + kk] * wv;
    a3 += s[3072 + kk] * wv;
    a4 += s[4096 + kk] * wv;
  }
  red[(kg * 5 + 0) * 64 + col] = a0;
  red[(kg * 5 + 1) * 64 + col] = a1;
  red[(kg * 5 + 2) * 64 + col] = a2;
  red[(kg * 5 + 3) * 64 + col] = a3;
  red[(kg * 5 + 4) * 64 + col] = a4;
  __syncthreads();
  if (tid < 64) {
    float b = p.ada_b[layer * 3072 + n];
    float* mods = (float*)(p.ws + OFF_MODS) + layer * 5 * 3072;
#pragma unroll
    for (int v = 0; v < 5; ++v)
      mods[v * 3072 + n] = red[(0 * 5 + v) * 64 + col] + red[(1 * 5 + v) * 64 + col] + red[(2 * 5 + v) * 64 + col] + red[(3 * 5 + v) * 64 + col] + b;
  }
}

__device__ __forceinline__ void job_hid(const Params& p, int j, char* smem) {
  float* zs = (float*)smem;
  float* h1 = zs + 160;
  const int layer = j / 2112, rb = j % 2112, tid = get_tid(), li = tid >> 6, jj = tid & 63;
  const int R = rb * 4 + li;
  const int L = (R < 8192) ? 8192 : 256;
  const int l = (R < 8192) ? R : R - 8192;
  __syncthreads();
  if (jj < 33) {
    float val;
    if (jj == 0) {
      val = (float)l / (float)(L - 1);
    } else {
      int b = (jj - 1) & 15;
      float f = 1e-4f + (float)b * ((15.0f - 1e-4f) / 15.0f);
      float w = 6.283185307179586f * (float)l / (float)L;
      float a = f * w;
      val = (jj <= 16) ? cosf(a) : -sinf(a);
    }
    zs[li * 40 + jj] = val;
  }
  __syncthreads();
  const float* w1 = p.hy_w1 + layer * 33 * 64;
  const float* w2 = p.hy_w2 + layer * 64 * 64;
  float a = p.hy_b1[layer * 64 + jj];
  for (int k = 0; k < 33; ++k) a += zs[li * 40 + k] * w1[k * 64 + jj];
  const float fr = p.hy_freq[layer * 64 + jj];
  h1[li * 64 + jj] = sinf(fr * a);
  __syncthreads();
  float a2 = p.hy_b2[layer * 64 + jj];
  for (int k = 0; k < 64; ++k) a2 += h1[li * 64 + k] * w2[k * 64 + jj];
  float* hid2 = (float*)(p.ws + OFF_HID2);
  hid2[((size_t)layer * 8448 + R) * 64 + jj] = sinf(fr * a2);
}

__device__ __forceinline__ void job_tw(const Params& p, int j) {
  const int k = j * 256 + get_tid();
  float sn, cs;
  sincospif((float)k / 8192.0f, &sn, &cs);
  float2* tw = (float2*)(p.ws + OFF_TW);
  tw[k] = make_float2(cs, -sn);
}

__device__ __forceinline__ void job_rope(const Params& p, int j) {
  const int idx = j * 256 + get_tid();
  const int t = idx >> 4, jj = idx & 15;
  const float pos = (jj < 8) ? (float)(t >> 6) : (float)(t & 63);
  const float inv = powf(10000.0f, -(float)(jj & 7) / 8.0f);
  float sn, cs;
  sincosf(pos * inv, &sn, &cs);
  ((float2*)(p.ws + OFF_ROPE))[idx] = make_float2(cs, sn);
}

__device__ __forceinline__ void tr_tile(const float* src, int ld, int nvalid, int k0, bf16_t* dst, int ldd, char* smem) {
  float* ts = (float*)smem;
  const int tid = get_tid(), a = tid & 63, b4 = tid >> 6;
  __syncthreads();
#pragma unroll 4
  for (int i = 0; i < 16; ++i) {
    int k = i * 4 + b4;
    ts[k * 65 + a] = (a < nvalid) ? src[(size_t)(k0 + k) * ld + a] : 0.f;
  }
  __syncthreads();
#pragma unroll 4
  for (int i = 0; i < 16; ++i) {
    int n = i * 4 + b4;
    if (n < nvalid) dst[(size_t)n * ldd + k0 + a] = f2bf(ts[a * 65 + n]);
  }
}

__device__ __forceinline__ void job_hgen(const Params& p, int layer, int jj, char* smem) {
  bf16_t* Ah = (bf16_t*)smem;
  bf16_t* Al = Ah + 64 * 72;
  const int tid = get_tid(), lane = tid & 63, wave = tid >> 6, c = lane & 15, g = lane >> 4;
  const bool isc = jj >= 1024;
  const int q = isc ? jj - 1024 : jj;
  const int lb = q >> 3, cc = q & 7;
  const int L = isc ? 256 : 8192;
  const int l0 = lb * 64;
  const float* hid2 = (const float*)(p.ws + OFF_HID2) + ((size_t)layer * 8448 + (isc ? 8192 : 0) + l0) * 64;
  __syncthreads();
  for (int i = tid; i < 2048; i += 256) {
    const int r = i >> 5, k2 = (i & 31) * 2;
    const f32x2 v = *(const f32x2*)(hid2 + r * 64 + k2);
    const unsigned hi = pack2(v[0], v[1]);
    const unsigned lo = pack2(v[0] - lo2f(hi), v[1] - hi2f(hi));
    *(unsigned*)(Ah + r * 72 + k2) = hi;
    *(unsigned*)(Al + r * 72 + k2) = lo;
  }
  const int colw = cc * 256 + wave * 64;
  const float* w3 = p.hy_w3 + (size_t)layer * 64 * 2048 + colw + c;
  bf16x8 bh[2][4], bl[2][4];
#pragma unroll
  for (int ks = 0; ks < 2; ++ks)
#pragma unroll
    for (int ni = 0; ni < 4; ++ni) {
      float wv[8];
#pragma unroll
      for (int e = 0; e < 8; ++e) wv[e] = w3[(size_t)(ks * 32 + g * 8 + e) * 2048 + ni * 16];
      u32x4 h4, l4;
#pragma unroll
      for (int e2 = 0; e2 < 4; ++e2) {
        const unsigned hi = pack2(wv[2 * e2], wv[2 * e2 + 1]);
        h4[e2] = hi;
        l4[e2] = pack2(wv[2 * e2] - lo2f(hi), wv[2 * e2 + 1] - hi2f(hi));
      }
      bh[ks][ni] = __builtin_bit_cast(bf16x8, h4);
      bl[ks][ni] = __builtin_bit_cast(bf16x8, l4);
    }
  __syncthreads();
  f32x4 acc[4][4];
#pragma unroll
  for (int mi = 0; mi < 4; ++mi)
#pragma unroll
    for (int ni = 0; ni < 4; ++ni) acc[mi][ni] = f32x4{0.f, 0.f, 0.f, 0.f};
#pragma unroll
  for (int ks = 0; ks < 2; ++ks)
#pragma unroll
    for (int mi = 0; mi < 4; ++mi) {
      const bf16x8 ah = *(const bf16x8*)(Ah + (mi * 16 + c) * 72 + ks * 32 + g * 8);
      const bf16x8 al = *(const bf16x8*)(Al + (mi * 16 + c) * 72 + ks * 32 + g * 8);
#pragma unroll
      for (int ni = 0; ni < 4; ++ni) {
        acc[mi][ni] = __builtin_amdgcn_mfma_f32_16x16x32_bf16(bl[ks][ni], ah, acc[mi][ni], 0, 0, 0);
        acc[mi][ni] = __builtin_amdgcn_mfma_f32_16x16x32_bf16(bh[ks][ni], al, acc[mi][ni], 0, 0, 0);
        acc[mi][ni] = __builtin_amdgcn_mfma_f32_16x16x32_bf16(bh[ks][ni], ah, acc[mi][ni], 0, 0, 0);
      }
    }
  const float mind = -3.0701134573253945f, maxd = -15.350567286626973f;
  float* outb = isc ? (float*)(p.ws + OFF_HTC) : (float*)(p.ws + OFF_PA1);
  const int ldo = isc ? 256 : 8192;
  float* psb = isc ? ((float*)(p.ws + OFF_PSUMC) + lb * 2048) : ((float*)(p.ws + OFF_PSUM) + lb * 2048);
#pragma unroll
  for (int ni = 0; ni < 4; ++ni)
#pragma unroll
    for (int j = 0; j < 4; ++j) {
      const int col = colw + ni * 16 + g * 4 + j;
      const float delta = fabsf(mind + (float)(col & 511) * ((maxd - mind) / 511.0f));
      float sum = 0.f;
#pragma unroll
      for (int mi = 0; mi < 4; ++mi) {
        const int lag = l0 + mi * 16 + c;
        const float t = (float)lag / (float)(L - 1);
        const float v = acc[mi][ni][j] * __expf(-t * delta);
        sum += fabsf(v);
        outb[(size_t)col * ldo + lag] = v;
      }
      sum += __shfl_xor(sum, 1);
      sum += __shfl_xor(sum, 2);
      sum += __shfl_xor(sum, 4);
      sum += __shfl_xor(sum, 8);
      if (c == 0) psb[col] = sum;
    }
}

typedef f32x2 C;
__device__ __forceinline__ C cmul(C a, C b) { return C{a[0] * b[0] - a[1] * b[1], a[0] * b[1] + a[1] * b[0]}; }
__device__ __forceinline__ C cmulc(C a, C b) { return C{a[0] * b[0] + a[1] * b[1], a[1] * b[0] - a[0] * b[1]}; }
__device__ __forceinline__ C cmuli_neg(C a) { return C{a[1], -a[0]}; }
__device__ __forceinline__ C cis_rev(float r) { return C{__builtin_amdgcn_cosf(r), __builtin_amdgcn_sinf(r)}; }

template <int S8>
__device__ __forceinline__ void r8_fwd_pass(float2* sm, const int tid) {
  const float h = 0.70710678118654752f;
#pragma unroll 2
  for (int b = 0; b < 4; ++b) {
    const int bidx = tid + 256 * b;
    const int j = bidx & (S8 - 1);
    const int base = ((bidx - j) << 3) + j;
    C x[8];
#pragma unroll
    for (int q = 0; q < 8; ++q) { float2 v = sm[base + q * S8]; x[q] = C{v.x, v.y}; }
    const C T1 = cis_rev(-(float)j * (1.0f / (float)(8 * S8)));
    const C T2 = cmul(T1, T1), T3 = cmul(T2, T2);
    const C tw1[4] = {T1, cmul(T1, C{h, -h}), cmuli_neg(T1), cmul(T1, C{-h, -h})};
#pragma unroll
    for (int q = 0; q < 4; ++q) { C a = x[q], d = x[q + 4]; x[q] = a + d; x[q + 4] = cmul(a - d, tw1[q]); }
    const C T2i = cmuli_neg(T2);
#pragma unroll
    for (int g = 0; g < 8; g += 4) {
      { C a = x[g], d = x[g + 2]; x[g] = a + d; x[g + 2] = cmul(a - d, T2); }
      { C a = x[g + 1], d = x[g + 3]; x[g + 1] = a + d; x[g + 3] = cmul(a - d, T2i); }
    }
#pragma unroll
    for (int q = 0; q < 8; q += 2) { C a = x[q], d = x[q + 1]; x[q] = a + d; x[q + 1] = cmul(a - d, T3); }
#pragma unroll
    for (int q = 0; q < 8; ++q) sm[base + q * S8] = make_float2(x[q][0], x[q][1]);
  }
  __syncthreads();
}

template <int S8>
__device__ __forceinline__ void r8_inv_pass(float2* sm, const int tid) {
  const float h = 0.70710678118654752f;
#pragma unroll 2
  for (int b = 0; b < 4; ++b) {
    const int bidx = tid + 256 * b;
    const int j = bidx & (S8 - 1);
    const int base = ((bidx - j) << 3) + j;
    C x[8];
#pragma unroll
    for (int q = 0; q < 8; ++q) { float2 v = sm[base + q * S8]; x[q] = C{v.x, v.y}; }
    const C T1 = cis_rev(-(float)j * (1.0f / (float)(8 * S8)));
    const C T2 = cmul(T1, T1), T3 = cmul(T2, T2);
#pragma unroll
    for (int q = 0; q < 8; q += 2) { C a = x[q], d = cmulc(x[q + 1], T3); x[q] = a + d; x[q + 1] = a - d; }
    const C T2i = cmuli_neg(T2);
#pragma unroll
    for (int g = 0; g < 8; g += 4) {
      { C a = x[g], d = cmulc(x[g + 2], T2); x[g] = a + d; x[g + 2] = a - d; }
      { C a = x[g + 1], d = cmulc(x[g + 3], T2i); x[g + 1] = a + d; x[g + 3] = a - d; }
    }
    const C tw1[4] = {T1, cmul(T1, C{h, -h}), cmuli_neg(T1), cmul(T1, C{-h, -h})};
#pragma unroll
    for (int q = 0; q < 4; ++q) { C a = x[q], d = cmulc(x[q + 4], tw1[q]); x[q] = a + d; x[q + 4] = a - d; }
#pragma unroll
    for (int q = 0; q < 8; ++q) sm[base + q * S8] = make_float2(x[q][0], x[q][1]);
  }
  __syncthreads();
}

#define W16X(k) ((k) == 0 ? 1.0f : (k) == 1 ? 0.92387953251128674f : (k) == 2 ? 0.70710678118654752f : (k) == 3 ? 0.38268343236508977f : (k) == 4 ? 0.0f : (k) == 5 ? -0.38268343236508977f : (k) == 6 ? -0.70710678118654752f : -0.92387953251128674f)
#define W16Y(k) ((k) == 0 ? 0.0f : (k) == 1 ? -0.38268343236508977f : (k) == 2 ? -0.70710678118654752f : (k) == 3 ? -0.92387953251128674f : (k) == 4 ? -1.0f : (k) == 5 ? -0.92387953251128674f : (k) == 6 ? -0.70710678118654752f : -0.38268343236508977f)

__device__ __forceinline__ void fwd16(C (&e)[16]) {
#pragma unroll
  for (int k = 0; k < 8; ++k) { C a = e[k], d = e[k + 8]; e[k] = a + d; e[k + 8] = cmul(a - d, C{W16X(k), W16Y(k)}); }
#pragma unroll
  for (int g = 0; g < 16; g += 8)
#pragma unroll
    for (int k = 0; k < 4; ++k) { C a = e[g + k], d = e[g + k + 4]; e[g + k] = a + d; e[g + k + 4] = cmul(a - d, C{W16X(2 * k), W16Y(2 * k)}); }
#pragma unroll
  for (int g = 0; g < 16; g += 4)
#pragma unroll
    for (int k = 0; k < 2; ++k) { C a = e[g + k], d = e[g + k + 2]; e[g + k] = a + d; e[g + k + 2] = cmul(a - d, C{W16X(4 * k), W16Y(4 * k)}); }
#pragma unroll
  for (int k = 0; k < 16; k += 2) { C a = e[k], d = e[k + 1]; e[k] = a + d; e[k + 1] = a - d; }
}
__device__ __forceinline__ void inv16(C (&e)[16]) {
#pragma unroll
  for (int k = 0; k < 16; k += 2) { C a = e[k], d = e[k + 1]; e[k] = a + d; e[k + 1] = a - d; }
#pragma unroll
  for (int g = 0; g < 16; g += 4)
#pragma unroll
    for (int k = 0; k < 2; ++k) { C a = e[g + k], d = cmulc(e[g + k + 2], C{W16X(4 * k), W16Y(4 * k)}); e[g + k] = a + d; e[g + k + 2] = a - d; }
#pragma unroll
  for (int g = 0; g < 16; g += 8)
#pragma unroll
    for (int k = 0; k < 4; ++k) { C a = e[g + k], d = cmulc(e[g + k + 4], C{W16X(2 * k), W16Y(2 * k)}); e[g + k] = a + d; e[g + k + 4] = a - d; }
#pragma unroll
  for (int k = 0; k < 8; ++k) { C a = e[k], d = cmulc(e[k + 8], C{W16X(k), W16Y(k)}); e[k] = a + d; e[k + 8] = a - d; }
}

__device__ __forceinline__ void ld16(const float2* src, C (&e)[16]) {
#pragma unroll
  for (int k = 0; k < 8; ++k) {
    f32x4 v = *(const f32x4*)(src + 2 * k);
    e[2 * k] = C{v[0], v[1]};
    e[2 * k + 1] = C{v[2], v[3]};
  }
}
__device__ __forceinline__ void st16(float2* dst, const C (&e)[16]) {
#pragma unroll
  for (int k = 0; k < 8; ++k) *(f32x4*)(dst + 2 * k) = f32x4{e[2 * k][0], e[2 * k][1], e[2 * k + 1][0], e[2 * k + 1][1]};
}

__device__ __forceinline__ void fft_fwd_to_global(float2* sm, const int tid, float2* __restrict__ dst, float scale) {
  r8_fwd_pass<1024>(sm, tid);
  r8_fwd_pass<128>(sm, tid);
  r8_fwd_pass<16>(sm, tid);
#pragma unroll 1
  for (int bb = 0; bb < 2; ++bb) {
    const int blk = tid + 256 * bb;
    C e[16];
    ld16(sm + 16 * blk, e);
    fwd16(e);
#pragma unroll
    for (int k = 0; k < 16; ++k) e[k] *= scale;
    st16(dst + 16 * blk, e);
  }
}

__device__ __forceinline__ void fft_conv_core(float2* sm, const int tid, const float2* __restrict__ sp) {
  r8_fwd_pass<1024>(sm, tid);
  r8_fwd_pass<128>(sm, tid);
  r8_fwd_pass<16>(sm, tid);
#pragma unroll 1
  for (int bb = 0; bb < 2; ++bb) {
    const int blk = tid + 256 * bb;
    C e[16], kk[16];
    ld16(sp + 16 * blk, kk);
    ld16(sm + 16 * blk, e);
    fwd16(e);
#pragma unroll
    for (int k = 0; k < 16; ++k) e[k] = cmul(e[k], kk[k]);
    inv16(e);
    st16(sm + 16 * blk, e);
  }
  __syncthreads();
  r8_inv_pass<16>(sm, tid);
  r8_inv_pass<128>(sm, tid);
  r8_inv_pass<1024>(sm, tid);
}

__device__ __forceinline__ void fft_fwd_inplace(float2* sm, const int tid) {
  r8_fwd_pass<1024>(sm, tid);
  r8_fwd_pass<128>(sm, tid);
  r8_fwd_pass<16>(sm, tid);
#pragma unroll 1
  for (int bb = 0; bb < 2; ++bb) {
    const int blk = tid + 256 * bb;
    C e[16];
    ld16(sm + 16 * blk, e);
    fwd16(e);
    st16(sm + 16 * blk, e);
  }
  __syncthreads();
}

__device__ __forceinline__ void job_filtfft(const Params& p, int j, char* smem) {
  float2* sm = (float2*)smem;
  float* red = (float*)smem;
  const int tid = get_tid();
  const int par = j & 1, c = j >> 1;
  const float* psum = (const float*)(p.ws + OFF_PSUM);
  const float2* tw = (const float2*)(p.ws + OFF_TW);
  __syncthreads();
  float v0 = 0.f, v1 = 0.f;
  if (tid < 128) {
    v0 = psum[tid * 2048 + c] + psum[tid * 2048 + 1024 + c];
    v1 = psum[tid * 2048 + 512 + c] + psum[tid * 2048 + 1536 + c];
  }
  v0 = wave_sum(v0);
  v1 = wave_sum(v1);
  if ((tid & 63) == 0) { red[(tid >> 6) * 2] = v0; red[(tid >> 6) * 2 + 1] = v1; }
  __syncthreads();
  const float S0 = red[0] + red[2] + red[4] + red[6];
  const float S1 = red[1] + red[3] + red[5] + red[7];
  __syncthreads();
  const float* hf = (const float*)(p.ws + OFF_PA1);
  const float* h00 = hf + (size_t)c * 8192;
  const float* h01 = hf + (size_t)(512 + c) * 8192;
  const float* h10 = hf + (size_t)(1024 + c) * 8192;
  const float* h11 = hf + (size_t)(1536 + c) * 8192;
#pragma unroll 4
  for (int i = 0; i < 32; ++i) {
    const int n = tid + 256 * i;
    const float a0 = h00[n], a1 = h01[n];
    const float b0 = (n >= 1) ? h10[8192 - n] : 0.f;
    const float b1 = (n >= 1) ? h11[8192 - n] : 0.f;
    if (par == 0) {
      sm[n] = make_float2(a0 + b0, a1 + b1);
    } else {
      const float d0 = a0 - b0, d1 = a1 - b1;
      const float2 w = tw[n];
      sm[n] = make_float2(d0 * w.x - d1 * w.y, d0 * w.y + d1 * w.x);
    }
  }
  __syncthreads();
  fft_fwd_inplace(sm, tid);
  const float i0 = 0.5f / S0, i1 = 0.5f / S1;
  float2* spec0 = (float2*)(p.ws + OFF_SPEC) + (size_t)(c * 2 + par) * 8192;
  float2* spec1 = (float2*)(p.ws + OFF_SPEC) + (size_t)((512 + c) * 2 + par) * 8192;
#pragma unroll 4
  for (int i = 0; i < 32; ++i) {
    const int pidx = tid + 256 * i;
    const int m = (int)(__brev((unsigned)pidx) >> 19);
    const int mp = par ? (8191 - m) : ((8192 - m) & 8191);
    const int pp = (int)(__brev((unsigned)mp) >> 19);
    const float2 z1 = sm[pidx], z2 = sm[pp];
    spec0[pidx] = make_float2((z1.x + z2.x) * i0, (z1.y - z2.y) * i0);
    spec1[pidx] = make_float2((z1.y + z2.y) * i1, (z2.x - z1.x) * i1);
  }
}

__device__ __forceinline__ float ht_conv(const bf16_t* row, int t, int Lseg, float w0, float w1, float w2, float b) {
  float hm = (t > 0) ? bf2f(row[t - 1]) : 0.f;
  float h0 = bf2f(row[t]);
  float hp = (t < Lseg - 1) ? bf2f(row[t + 1]) : 0.f;
  return w0 * hm + w1 * h0 + w2 * hp + b;
}

__device__ __forceinline__ void load8_seq(const bf16_t* row, int n0, bool doconv, float w0, float w1, float w2, float b,
                                          float (&out)[8]) {
  const u32x4 v = *(const u32x4*)(row + n0);
  float h[10];
#pragma unroll
  for (int k = 0; k < 4; ++k) { h[1 + 2 * k] = lo2f(v[k]); h[2 + 2 * k] = hi2f(v[k]); }
  if (doconv) {
    h[0] = (n0 > 0) ? bf2f(row[n0 - 1]) : 0.f;
    h[9] = (n0 + 8 < 8192) ? bf2f(row[n0 + 8]) : 0.f;
#pragma unroll
    for (int k = 0; k < 8; ++k) out[k] = w0 * h[k] + w1 * h[k + 1] + w2 * h[k + 2] + b;
  } else {
#pragma unroll
    for (int k = 0; k < 8; ++k) out[k] = h[k + 1];
  }
}

__device__ __forceinline__ void job_fftconv(const Params& p, int layer, int c, int which, char* smem) {
  float2* sm = (float2*)smem;
  const int tid = get_tid();
  bf16_t* HT = (bf16_t*)(p.ws + OFF_HT);
  const float2* spec = (const float2*)(p.ws + OFF_SPEC) + (size_t)((which * 512 + c) * 2) * 8192;
  const float* cw = p.hy_conv_w + layer * 3 * 1536;
  const float* cb = p.hy_conv_b + layer * 1536;
  const int cx = (which == 0) ? 512 + c : 1024 + c;
  const float uw0 = cw[c], uw1 = cw[1536 + c], uw2 = cw[3072 + c], ub = cb[c];
  const float xw0 = cw[cx], xw1 = cw[1536 + cx], xw2 = cw[3072 + cx], xb = cb[cx];
  const float skip = p.hy_skip[layer * 1024 + which * 512 + c];
  bf16_t* urow = HT + (size_t)c * T2;
  const bf16_t* xrow = HT + (size_t)cx * T2;
  const bf16_t* zrow = HT + (size_t)(1536 + c) * T2;
  const bool uconv = (which == 0);
  f32x2 y[32];
  for (int par = 0; par < 2; ++par) {
    __syncthreads();
#pragma unroll 1
    for (int i = 0; i < 4; ++i) {
      const int n0 = tid * 8 + 2048 * i;
      float a0[8], a1[8];
      load8_seq(urow, n0, uconv, uw0, uw1, uw2, ub, a0);
      load8_seq(urow + 8192, n0, uconv, uw0, uw1, uw2, ub, a1);
#pragma unroll
      for (int k = 0; k < 8; k += 2) {
        C z0 = C{a0[k], a1[k]}, z1 = C{a0[k + 1], a1[k + 1]};
        if (par == 1) {
          z0 = cmul(z0, cis_rev(-(float)(n0 + k) * (1.0f / 16384.0f)));
          z1 = cmul(z1, cis_rev(-(float)(n0 + k + 1) * (1.0f / 16384.0f)));
        }
        *(f32x4*)(sm + n0 + k) = f32x4{z0[0], z0[1], z1[0], z1[1]};
      }
    }
    __syncthreads();
    fft_conv_core(sm, tid, spec + par * 8192);
    if (par == 0) {
#pragma unroll
      for (int i = 0; i < 32; ++i) { float2 z = sm[tid + 256 * i]; y[i][0] = z.x; y[i][1] = z.y; if ((i & 7) == 7) __builtin_amdgcn_sched_barrier(0); }
    } else {
#pragma unroll 4
      for (int i = 0; i < 32; ++i) {
        const int n = tid + 256 * i;
        float2 z = sm[n];
        C w = cis_rev(-(float)n * (1.0f / 16384.0f));
        sm[n] = make_float2(z.x * w[0] + z.y * w[1], z.y * w[0] - z.x * w[1]);
      }
#pragma unroll
      for (int i = 0; i < 32; ++i) {
        const int n = tid + 256 * i;
        float2 z = sm[n];
        sm[n] = make_float2(y[i][0] + z.x, y[i][1] + z.y);
        if ((i & 7) == 7) __builtin_amdgcn_sched_barrier(0);
      }
    }
  }
  __syncthreads();
  const float sc = 1.0f / 16384.0f;
#pragma unroll 1
  for (int i = 0; i < 4; ++i) {
    const int n0 = tid * 8 + 2048 * i;
    float u0[8], u1[8], x0[8], x1[8], g0[8], g1[8];
    load8_seq(urow, n0, uconv, uw0, uw1, uw2, ub, u0);
    load8_seq(urow + 8192, n0, uconv, uw0, uw1, uw2, ub, u1);
    load8_seq(xrow, n0, true, xw0, xw1, xw2, xb, x0);
    load8_seq(xrow + 8192, n0, true, xw0, xw1, xw2, xb, x1);
    if (which == 1) {
      load8_seq(zrow, n0, false, 0.f, 0.f, 0.f, 0.f, g0);
      load8_seq(zrow + 8192, n0, false, 0.f, 0.f, 0.f, 0.f, g1);
    }
#pragma unroll
    for (int k = 0; k < 8; k += 2) {
      f32x4 yy = *(const f32x4*)(sm + n0 + k);
      float v00 = (yy[0] * sc + u0[k] * skip) * x0[k];
      float v10 = (yy[1] * sc + u1[k] * skip) * x1[k];
      float v01 = (yy[2] * sc + u0[k + 1] * skip) * x0[k + 1];
      float v11 = (yy[3] * sc + u1[k + 1] * skip) * x1[k + 1];
      if (which == 1) {
        v00 *= silu_f(g0[k]); v10 *= silu_f(g1[k]); v01 *= silu_f(g0[k + 1]); v11 *= silu_f(g1[k + 1]);
      }
      *(f32x4*)(sm + n0 + k) = f32x4{v00, v10, v01, v11};
    }
  }
  __syncthreads();
#pragma unroll 2
  for (int i = 0; i < 4; ++i) {
    const int n0 = tid * 8 + 2048 * i;
    u32x4 o0, o1;
#pragma unroll
    for (int k = 0; k < 8; k += 2) {
      f32x4 v = *(const f32x4*)(sm + n0 + k);
      o0[k >> 1] = pack2(v[0], v[2]);
      o1[k >> 1] = pack2(v[1], v[3]);
    }
    *(u32x4*)(urow + n0) = o0;
    *(u32x4*)(urow + 8192 + n0) = o1;
  }
}

__device__ __forceinline__ void job_ctxconv(const Params& p, int layer, int c, int bl, int which, char* smem) {
  float* us = (float*)smem;
  float* h0 = us + 256;
  float* h1 = h0 + 256;
  const int t = get_tid();
  bf16_t* HT = (bf16_t*)(p.ws + OFF_HT);
  const float* cw = p.hy_conv_w + layer * 3 * 1536;
  const float* cb = p.hy_conv_b + layer * 1536;
  const int cx = (which == 0) ? 512 + c : 1024 + c;
  const float skip = p.hy_skip[layer * 1024 + which * 512 + c];
  const int cbase = 16384 + bl * 256;
  bf16_t* urow = HT + (size_t)c * T2 + cbase;
  const bf16_t* xrow = HT + (size_t)cx * T2 + cbase;
  const bf16_t* zrow = HT + (size_t)(1536 + c) * T2 + cbase;
  float u;
  if (which == 0)
    u = ht_conv(urow, t, 256, cw[c], cw[1536 + c], cw[3072 + c], cb[c]);
  else
    u = bf2f(urow[t]);
  const int col0 = which * 512 + c, col1 = 1024 + which * 512 + c;
  const float* HTc = (const float*)(p.ws + OFF_HTC);
  const float* psc = (const float*)(p.ws + OFF_PSUMC);
  float S = 0.f;
#pragma unroll
  for (int lb = 0; lb < 4; ++lb) S += psc[lb * 2048 + col0] + psc[lb * 2048 + col1];
  float* kk = h0;
  __syncthreads();
  us[t] = u;
  kk[255 + t] = HTc[(size_t)col0 * 256 + t];
  if (t >= 1) kk[255 - t] = HTc[(size_t)col1 * 256 + t];
  if (t == 0) kk[511] = 0.f;
  __syncthreads();
  float acc = 0.f;
  const float* kp = kk + 255 + t;
#pragma unroll 4
  for (int s4 = 0; s4 < 256; s4 += 4) {
    const f32x4 u4 = *(const f32x4*)(us + s4);
    acc += kp[-s4] * u4[0] + kp[-s4 - 1] * u4[1] + kp[-s4 - 2] * u4[2] + kp[-s4 - 3] * u4[3];
  }
  float yv = acc / S;
  float xg = ht_conv(xrow, t, 256, cw[cx], cw[1536 + cx], cw[3072 + cx], cb[cx]);
  float v = (yv + u * skip) * xg;
  if (which == 1) v *= silu_f(bf2f(zrow[t]));
  urow[t] = f2bf(v);
}

__device__ __forceinline__ void job_modnorm(const Params& p, int layer, int pass, int j) {
  const int tid_ = get_tid(), lane = tid_ & 63, wave = tid_ >> 6;
  const int r = j * 4 + wave;
  const float* xr;
  int v;
  if (r < 16384) {
    const int b = 2 * pass + (r >> 13), t = r & 8191;
    xr = (layer == 0 ? p.x : p.out) + ((size_t)b * 8192 + t) * 1024;
    v = b;
  } else {
    const int q = r - 16384;
    const int b = 2 * pass + (q >> 8), t = q & 255;
    xr = (layer == 0 ? p.ctx : (const float*)(p.ws + OFF_XCTX)) + ((size_t)b * 256 + t) * 1024;
    v = 4;
  }
  const float* mod = (const float*)(p.ws + OFF_MODS) + (layer * 5 + v) * 3072;
  const float* g = p.norm_g + layer * 1024;
  f32x4 xv[4];
  float ss = 0.f;
#pragma unroll
  for (int i = 0; i < 4; ++i) {
    xv[i] = *(const f32x4*)(xr + lane * 4 + 256 * i);
    ss += xv[i][0] * xv[i][0] + xv[i][1] * xv[i][1] + xv[i][2] * xv[i][2] + xv[i][3] * xv[i][3];
  }
  ss = wave_sum(ss);
  const float rstd = rsqrtf(ss * (1.0f / 1024.0f) + 1e-6f);
  bf16_t* hn = (bf16_t*)(p.ws + OFF_HN) + (size_t)r * 1024;
#pragma unroll
  for (int i = 0; i < 4; ++i) {
    const int col = lane * 4 + 256 * i;
    float4 gg = *(const float4*)(g + col);
    float4 sh = *(const float4*)(mod + col);
    float4 scl = *(const float4*)(mod + 1024 + col);
    f32x4 o;
    o[0] = xv[i][0] * rstd * gg.x * (1.f + scl.x) + sh.x;
    o[1] = xv[i][1] * rstd * gg.y * (1.f + scl.y) + sh.y;
    o[2] = xv[i][2] * rstd * gg.z * (1.f + scl.z) + sh.z;
    o[3] = xv[i][3] * rstd * gg.w * (1.f + scl.w) + sh.w;
    store_bf4(hn + col, o);
  }
}

__device__ __forceinline__ void job_mlanorm(const Params& p, int layer, int j) {
  const int tid_ = get_tid(), lane = tid_ & 63, wave = tid_ >> 6;
  const int r0 = j * 16 + wave * 4;
  bf16_t* row0 = (bf16_t*)(p.ws + OFF_PA2) + (size_t)r0 * 1184;
  const float* gq = p.mla_q_norm + layer * 384;
  const float* gkv = p.mla_kv_norm + layer * 256;
  unsigned u[4][3];
  u32x2 w[4];
  unsigned short k1[4], k2[4];
#pragma unroll
  for (int q = 0; q < 4; ++q) {
    const bf16_t* row = row0 + q * 1184;
#pragma unroll
    for (int i = 0; i < 3; ++i) u[q][i] = *(const unsigned*)(row + lane * 2 + 128 * i);
    w[q] = *(const u32x2*)(row + 384 + lane * 4);
    k1[q] = row[640 + (lane & 15)];
    k2[q] = row[656 + (lane & 15)];
  }
  float gqv[6], gkvv[4];
#pragma unroll
  for (int i = 0; i < 3; ++i) { gqv[2 * i] = gq[lane * 2 + 128 * i]; gqv[2 * i + 1] = gq[lane * 2 + 128 * i + 1]; }
#pragma unroll
  for (int i = 0; i < 4; ++i) gkvv[i] = gkv[lane * 4 + i];
#pragma unroll
  for (int q = 0; q < 4; ++q) {
    const int r = r0 + q;
    bf16_t* row = row0 + q * 1184;
    float ss = 0.f;
#pragma unroll
    for (int i = 0; i < 3; ++i) { float a = lo2f(u[q][i]), b = hi2f(u[q][i]); ss += a * a + b * b; }
    ss = wave_sum(ss);
    const float rstd = rsqrtf(ss * (1.0f / 384.0f) + 1e-6f);
#pragma unroll
    for (int i = 0; i < 3; ++i)
      *(unsigned*)(row + lane * 2 + 128 * i) = pack2(lo2f(u[q][i]) * rstd * gqv[2 * i], hi2f(u[q][i]) * rstd * gqv[2 * i + 1]);
    const float a0 = lo2f(w[q][0]), a1 = hi2f(w[q][0]), a2 = lo2f(w[q][1]), a3 = hi2f(w[q][1]);
    const float ss2 = wave_sum(a0 * a0 + a1 * a1 + a2 * a2 + a3 * a3);
    const float rstd2 = rsqrtf(ss2 * (1.0f / 256.0f) + 1e-6f);
    u32x2 o;
    o[0] = pack2(a0 * rstd2 * gkvv[0], a1 * rstd2 * gkvv[1]);
    o[1] = pack2(a2 * rstd2 * gkvv[2], a3 * rstd2 * gkvv[3]);
    *(u32x2*)(row + 384 + lane * 4) = o;
    if (lane < 16) {
      const float x1 = bf2f(k1[q]), x2 = bf2f(k2[q]);
      float o1 = x1, o2 = x2;
      if (r < 16384) {
        const int t = r & 8191;
        const float2 cssn = ((const float2*)(p.ws + OFF_ROPE))[t * 16 + lane];
        o1 = x1 * cssn.x - x2 * cssn.y;
        o2 = x1 * cssn.y + x2 * cssn.x;
      }
      bf16_t* kf = (bf16_t*)(p.ws + OFF_KF) + (size_t)r * 768;
      const bf16_t b1 = f2bf(o1), b2 = f2bf(o2);
#pragma unroll
      for (int h = 0; h < 8; ++h) {
        kf[h * 96 + 64 + lane] = b1;
        kf[h * 96 + 80 + lane] = b2;
      }
    }
  }
}

__device__ __forceinline__ void job_shortconv(const Params& p, int layer, int j) {
  const int tid = get_tid();
  const bf16_t* PA1 = (const bf16_t*)(p.ws + OFF_PA1);
  bf16_t* AA = (bf16_t*)(p.ws + OFF_AA);
  const float* cw = p.sc_conv_w + layer * 3 * 512;
  const float* cb = p.sc_conv_b + layer * 512;
  const int ch = (tid & 63) * 8;
  for (int it = 0; it < 4; ++it) {
    const int r = j * 16 + it * 4 + (tid >> 6);
    int t, Ls;
    if (r < 16384) { t = r & 8191; Ls = 8192; } else { t = (r - 16384) & 255; Ls = 256; }
    const bf16_t* row = PA1 + (size_t)r * 2048;
    uint4 x0 = *(const uint4*)(row + ch), g0 = *(const uint4*)(row + 1024 + ch);
    uint4 gb = *(const uint4*)(row + 512 + ch), za = *(const uint4*)(row + 1536 + ch);
    uint4 xm = make_uint4(0, 0, 0, 0), gm = xm, xp = xm, gp = xm;
    if (t > 0) { xm = *(const uint4*)(row - 2048 + ch); gm = *(const uint4*)(row - 2048 + 1024 + ch); }
    if (t < Ls - 1) { xp = *(const uint4*)(row + 2048 + ch); gp = *(const uint4*)(row + 2048 + 1024 + ch); }
    const unsigned* x0p = (const unsigned*)&x0; const unsigned* g0p = (const unsigned*)&g0;
    const unsigned* xmp = (const unsigned*)&xm; const unsigned* gmp = (const unsigned*)&gm;
    const unsigned* xpp = (const unsigned*)&xp; const unsigned* gpp = (const unsigned*)&gp;
    const unsigned* gbp = (const unsigned*)&gb; const unsigned* zap = (const unsigned*)&za;
    uint4 o;
    unsigned* op = (unsigned*)&o;
#pragma unroll
    for (int e = 0; e < 4; ++e) {
      const int c0 = ch + 2 * e;
      float r0, r1;
      {
        float pm = lo2f(xmp[e]) * lo2f(gmp[e]), p0 = lo2f(x0p[e]) * lo2f(g0p[e]), pp = lo2f(xpp[e]) * lo2f(gpp[e]);
        float cv = cw[c0] * pm + cw[512 + c0] * p0 + cw[1024 + c0] * pp + cb[c0];
        r0 = silu_f(lo2f(zap[e])) * lo2f(gbp[e]) * cv;
      }
      {
        float pm = hi2f(xmp[e]) * hi2f(gmp[e]), p0 = hi2f(x0p[e]) * hi2f(g0p[e]), pp = hi2f(xpp[e]) * hi2f(gpp[e]);
        float cv = cw[c0 + 1] * pm + cw[512 + c0 + 1] * p0 + cw[1024 + c0 + 1] * pp + cb[c0 + 1];
        r1 = silu_f(hi2f(zap[e])) * hi2f(gbp[e]) * cv;
      }
      op[e] = pack2(r0, r1);
    }
    *(uint4*)(AA + (size_t)r * 512 + ch) = o;
  }
}

__device__ __forceinline__ void job_attn(const Params& p, int bl, int h, int qb, bool isctx, char* smem) {
  const int tid = get_tid512(), lane = tid & 63, wave = tid >> 6, c = lane & 15, g = lane >> 4;
  const bf16_t* Q = (const bf16_t*)(p.ws + OFF_Q);
  const bf16_t* KF = (const bf16_t*)(p.ws + OFF_KF);
  const bf16_t* VT = (const bf16_t*)(p.ws + OFF_VT);
  const bf16_t* PA2 = (const bf16_t*)(p.ws + OFF_PA2);
  bf16_t* AM = (bf16_t*)(p.ws + OFF_AM);
  const int qr0 = isctx ? 16384 + bl * 256 : bl * 8192 + qb * 256;
  bf16_t* Qs = (bf16_t*)smem;
  const float qscale = 0.10206207261596577f * 1.4426950408889634f;
  __syncthreads();
  for (int u = tid; u < 2560; u += 512) {
    const int row = u / 10, k = u % 10;
    const bf16_t* src = Q + (size_t)(qr0 + row) * 768 + h * 96;
    bf16_t* dst = Qs + row * 104;
    if (k < 8) {
      u32x4 v = *(const u32x4*)(src + k * 8);
#pragma unroll
      for (int e = 0; e < 4; ++e) v[e] = pack2(lo2f(v[e]) * qscale, hi2f(v[e]) * qscale);
      *(u32x4*)(dst + k * 8) = v;
    } else {
      const int jh = k - 8;
      const u32x4 a1 = *(const u32x4*)(src + 64 + jh * 8), a2 = *(const u32x4*)(src + 80 + jh * 8);
      const int t = qb * 256 + row;
      const f32x4* rp = (const f32x4*)(p.ws + OFF_ROPE) + (size_t)(isctx ? 0 : t) * 8 + jh * 4;
      u32x4 r1, r2;
#pragma unroll
      for (int e2 = 0; e2 < 4; ++e2) {
        float xa0 = lo2f(a1[e2]), xa1 = hi2f(a1[e2]), xb0 = lo2f(a2[e2]), xb1 = hi2f(a2[e2]);
        float oa0 = xa0, oa1 = xa1, ob0 = xb0, ob1 = xb1;
        if (!isctx) {
          const f32x4 cs2 = rp[e2];
          oa0 = xa0 * cs2[0] - xb0 * cs2[1];
          ob0 = xa0 * cs2[1] + xb0 * cs2[0];
          oa1 = xa1 * cs2[2] - xb1 * cs2[3];
          ob1 = xa1 * cs2[3] + xb1 * cs2[2];
        }
        r1[e2] = pack2(oa0 * qscale, oa1 * qscale);
        r2[e2] = pack2(ob0 * qscale, ob1 * qscale);
      }
      *(u32x4*)(dst + 64 + jh * 8) = r1;
      *(u32x4*)(dst + 80 + jh * 8) = r2;
    }
  }
  __syncthreads();
  bf16x8 bq[2][3];
#pragma unroll
  for (int qs = 0; qs < 2; ++qs)
#pragma unroll
    for (int ks = 0; ks < 3; ++ks) bq[qs][ks] = *(const bf16x8*)(Qs + (wave * 32 + qs * 16 + c) * 104 + ks * 32 + g * 8);
  __syncthreads();

  bf16_t* Ks0 = (bf16_t*)smem;
  bf16_t* Vs0 = (bf16_t*)(smem + 2 * 26624);
  const int nt = isctx ? 2 : 66;
  const int ctxbase = 16384 + bl * 256, latbase = bl * 8192;
  u32x4 rk0, rk1, rk2, rv0, rv1;
  const int kr0 = tid / 12, kc0 = tid % 12, kr1 = (tid + 512) / 12, kc1 = (tid + 512) % 12, kr2 = (tid + 1024) / 12,
            kc2 = (tid + 1024) % 12;
  const int vr0 = tid >> 4, vc0 = tid & 15;
#define ATT_GLOAD(it_)                                                                        \
  {                                                                                           \
    const int kb_ = ((it_) < 2) ? ctxbase + (it_) * 128 : latbase + ((it_) - 2) * 128;       \
    rk0 = *(const u32x4*)(KF + (size_t)(kb_ + kr0) * 768 + h * 96 + kc0 * 8);                \
    rk1 = *(const u32x4*)(KF + (size_t)(kb_ + kr1) * 768 + h * 96 + kc1 * 8);                \
    rk2 = *(const u32x4*)(KF + (size_t)(kb_ + kr2) * 768 + h * 96 + kc2 * 8);                \
    rv0 = *(const u32x4*)(VT + (size_t)(h * 64 + vr0) * T2 + kb_ + vc0 * 8);                  \
    rv1 = *(const u32x4*)(VT + (size_t)(h * 64 + vr0 + 32) * T2 + kb_ + vc0 * 8);             \
  }
#define ATT_LSTORE(buf_)                                                  \
  {                                                                       \
    bf16_t* Ks_ = Ks0 + (buf_) * 13312;                                   \
    bf16_t* Vs_ = Vs0 + (buf_) * 8704;                                    \
    *(u32x4*)(Ks_ + kr0 * 104 + kc0 * 8) = rk0;                           \
    *(u32x4*)(Ks_ + kr1 * 104 + kc1 * 8) = rk1;                           \
    *(u32x4*)(Ks_ + kr2 * 104 + kc2 * 8) = rk2;                           \
    *(u32x4*)(Vs_ + vr0 * 136 + vc0 * 8) = rv0;                           \
    *(u32x4*)(Vs_ + (vr0 + 32) * 136 + vc0 * 8) = rv1;                    \
  }
  f32x4 o[5][2];
#pragma unroll
  for (int ns = 0; ns < 5; ++ns)
#pragma unroll
    for (int qs = 0; qs < 2; ++qs) o[ns][qs] = f32x4{0.f, 0.f, 0.f, 0.f};
  const unsigned onesw = (c == 0) ? 0x3F803F80u : 0u;
  const bf16x8 vones = __builtin_bit_cast(bf16x8, u32x4{onesw, onesw, onesw, onesw});
  f32x4 negm[2] = {f32x4{0.f, 0.f, 0.f, 0.f}, f32x4{0.f, 0.f, 0.f, 0.f}};
#define MAX3(a_, b_, c_) __builtin_fmaxf(__builtin_fmaxf((a_), (b_)), (c_))
  ATT_GLOAD(0);
  ATT_LSTORE(0);
  __syncthreads();
  for (int it = 0; it < nt; ++it) {
    const int buf = it & 1;
    {
      const int itn = (it + 1 < nt) ? it + 1 : it;
      ATT_GLOAD(itn);
    }
    const bf16_t* Ks = Ks0 + buf * 13312;
    const bf16_t* Vs = Vs0 + buf * 8704;
    f32x4 s[8][2];
#pragma unroll
    for (int ks = 0; ks < 3; ++ks)
#pragma unroll
      for (int kt = 0; kt < 8; ++kt) {
        bf16x8 kf = *(const bf16x8*)(Ks + (kt * 16 + c) * 104 + ks * 32 + g * 8);
#pragma unroll
        for (int qs = 0; qs < 2; ++qs)
          s[kt][qs] = __builtin_amdgcn_mfma_f32_16x16x32_bf16(kf, bq[qs][ks], (ks == 0) ? negm[qs] : s[kt][qs], 0, 0, 0);
      }
    bf16x8 pb[4][2];
#pragma unroll
    for (int qs = 0; qs < 2; ++qs) {
      float mx;
      {
        float m8[8];
#pragma unroll
        for (int kt = 0; kt < 8; ++kt) m8[kt] = MAX3(s[kt][qs][0], s[kt][qs][1], __builtin_fmaxf(s[kt][qs][2], s[kt][qs][3]));
        const float ma = MAX3(m8[0], m8[1], m8[2]), mb = MAX3(m8[3], m8[4], m8[5]);
        mx = MAX3(ma, mb, __builtin_fmaxf(m8[6], m8[7]));
        const u32x2 r32_ = __builtin_amdgcn_permlane32_swap(__float_as_uint(mx), __float_as_uint(mx), false, false);
        mx = __builtin_fmaxf(__uint_as_float(r32_[0]), __uint_as_float(r32_[1]));
        const u32x2 r16_ = __builtin_amdgcn_permlane16_swap(__float_as_uint(mx), __float_as_uint(mx), false, false);
        mx = __builtin_fmaxf(__uint_as_float(r16_[0]), __uint_as_float(r16_[1]));
      }
      if (__ballot(mx > 8.0f) != 0ull) {
        const float delta = (mx > 8.0f) ? mx : 0.f;
        const float alpha = __builtin_amdgcn_exp2f(-delta);
#pragma unroll
        for (int kt = 0; kt < 8; ++kt) s[kt][qs] -= delta;
#pragma unroll
        for (int ns = 0; ns < 5; ++ns) o[ns][qs] *= alpha;
        negm[qs] -= delta;
      }
#pragma unroll
      for (int kt = 0; kt < 8; ++kt)
#pragma unroll
        for (int e = 0; e < 4; ++e) s[kt][qs][e] = __builtin_amdgcn_exp2f(s[kt][qs][e]);
#pragma unroll
      for (int i = 0; i < 4; ++i) {
        u32x4 t;
        t[0] = pack2(s[2 * i][qs][0], s[2 * i][qs][1]);
        t[1] = pack2(s[2 * i][qs][2], s[2 * i][qs][3]);
        t[2] = pack2(s[2 * i + 1][qs][0], s[2 * i + 1][qs][1]);
        t[3] = pack2(s[2 * i + 1][qs][2], s[2 * i + 1][qs][3]);
        pb[i][qs] = __builtin_bit_cast(bf16x8, t);
      }
    }
#pragma unroll
    for (int i = 0; i < 4; ++i) {
#pragma unroll
      for (int ns = 0; ns < 4; ++ns) {
        bf16x4 va = *(const bf16x4*)(Vs + (ns * 16 + c) * 136 + (2 * i) * 16 + g * 4);
        bf16x4 vb = *(const bf16x4*)(Vs + (ns * 16 + c) * 136 + (2 * i + 1) * 16 + g * 4);
        bf16x8 vf;
        vf[0] = va[0]; vf[1] = va[1]; vf[2] = va[2]; vf[3] = va[3];
        vf[4] = vb[0]; vf[5] = vb[1]; vf[6] = vb[2]; vf[7] = vb[3];
#pragma unroll
        for (int qs = 0; qs < 2; ++qs) o[ns][qs] = __builtin_amdgcn_mfma_f32_16x16x32_bf16(vf, pb[i][qs], o[ns][qs], 0, 0, 0);
      }
#pragma unroll
      for (int qs = 0; qs < 2; ++qs) o[4][qs] = __builtin_amdgcn_mfma_f32_16x16x32_bf16(vones, pb[i][qs], o[4][qs], 0, 0, 0);
    }
    ATT_LSTORE(buf ^ 1);
    __syncthreads();
  }
#undef MAX3
#pragma unroll
  for (int qs = 0; qs < 2; ++qs) {
    const float l = __shfl(o[4][qs][0], c);
    const float inv = 1.0f / l;
    const int r = qr0 + wave * 32 + qs * 16 + c;
#pragma unroll
    for (int ns = 0; ns < 4; ++ns) {
      const int col = h * 64 + ns * 16 + g * 4;
      u32x2 zz = *(const u32x2*)(PA2 + (size_t)r * 1184 + 672 + col);
      f32x4 v;
      v[0] = o[ns][qs][0] * inv * silu_f(lo2f(zz[0]));
      v[1] = o[ns][qs][1] * inv * silu_f(hi2f(zz[0]));
      v[2] = o[ns][qs][2] * inv * silu_f(lo2f(zz[1]));
      v[3] = o[ns][qs][3] * inv * silu_f(hi2f(zz[1]));
      store_bf4(AM + (size_t)r * 512 + col, v);
    }
  }
}

__device__ __forceinline__ void job_tr_ah(const Params& p, int j, char* smem) {
  bf16_t* ts = (bf16_t*)smem;
  const int tid = get_tid(), a = tid & 63, b4 = tid >> 6;
  const int ct = j & 7, tt = j >> 3;
  const bf16_t* HT = (const bf16_t*)(p.ws + OFF_HT);
  bf16_t* AH = (bf16_t*)(p.ws + OFF_PA1 + 34603008);
  __syncthreads();
#pragma unroll 4
  for (int i = 0; i < 16; ++i) {
    const int ch = i * 4 + b4;
    ts[ch * 66 + a] = HT[(size_t)(ct * 64 + ch) * T2 + tt * 64 + a];
  }
  __syncthreads();
#pragma unroll 4
  for (int i = 0; i < 16; ++i) {
    const int tok = i * 4 + b4;
    AH[(size_t)(tt * 64 + tok) * 512 + ct * 64 + a] = ts[a * 66 + tok];
  }
}

#define XB_TMO 128
#define XB_XCNT(j) (256 + 64 * (j))
#define XB_XSUB(j) (1280 + 64 * (j))
#define XB_XGEN(j) (2304 + 64 * (j))
#define XB_TOP 3328
#define XB_TOPGEN 3392
#define XCD_BAR_WORDS 3456
#define XB_SPIN_CAP (1u << 22)
__device__ __forceinline__ unsigned xb_ld(unsigned* p) { return __hip_atomic_load(p, __ATOMIC_RELAXED, __HIP_MEMORY_SCOPE_AGENT); }
__device__ __forceinline__ unsigned xb_add(unsigned* p, unsigned v) { return __hip_atomic_fetch_add(p, v, __ATOMIC_RELAXED, __HIP_MEMORY_SCOPE_AGENT); }
__device__ __forceinline__ unsigned xb_xcc_id() { return (unsigned)__builtin_amdgcn_s_getreg((3 << 11) | 20) & 0xFu; }
#define XB_SPIN(cond, bar)                                              \
  do {                                                                  \
    unsigned _sp = 0;                                                   \
    while (cond) {                                                      \
      __builtin_amdgcn_s_sleep(1);                                      \
      if ((++_sp & 255u) == 0u) {                                       \
        if (xb_ld(&(bar)[XB_TMO])) break;                               \
        if (_sp > XB_SPIN_CAP) { atomicAdd(&(bar)[XB_TMO], 1u); break; } \
      }                                                                 \
    }                                                                   \
  } while (0)

__device__ __forceinline__ void xb_census(unsigned* bar, unsigned x, unsigned& nloc, unsigned& nx) {
  unsigned cnt = 0u, mine = 0u;
#pragma unroll
  for (unsigned j = 0; j < 16; ++j) {
    const unsigned c = xb_ld(&bar[XB_XCNT(j)]);
    cnt += (c > 0u) ? 1u : 0u;
    mine = (j == x) ? c : mine;
  }
  nloc = mine > 0u ? mine : 1u;
  nx = cnt > 0u ? cnt : 1u;
}

__device__ __forceinline__ void xcd_barrier(unsigned* bar, unsigned x, unsigned nloc, unsigned nx) {
  asm volatile("s_waitcnt vmcnt(0)" ::: "memory");
  __syncthreads();
  if (threadIdx.x == 0) {
    __builtin_amdgcn_s_waitcnt(0);
    const unsigned old = xb_add(&bar[XB_XSUB(x)], 1u);
    const unsigned gen = old / nloc;
    if (old + 1u == (gen + 1u) * nloc) {
      __builtin_amdgcn_fence(__ATOMIC_RELEASE, "agent");
      asm volatile("s_waitcnt vmcnt(0)" ::: "memory");
      const unsigned og = xb_add(&bar[XB_TOP], 1u);
      const unsigned tg = og / nx;
      if (og + 1u == (tg + 1u) * nx) xb_add(&bar[XB_TOPGEN], 1u);
      else XB_SPIN(xb_ld(&bar[XB_TOPGEN]) == tg, bar);
      __builtin_amdgcn_fence(__ATOMIC_ACQUIRE, "agent");
      xb_add(&bar[XB_XGEN(x)], 1u);
      asm volatile("s_waitcnt vmcnt(0)" ::: "memory");
    } else {
      XB_SPIN(xb_ld(&bar[XB_XGEN(x)]) == gen, bar);
      __builtin_amdgcn_fence(__ATOMIC_ACQUIRE, "agent");
      asm volatile("s_waitcnt vmcnt(0)" ::: "memory");
    }
  }
  __syncthreads();
}

__global__ void __launch_bounds__(512, 2) mega(Params p0) {
  cg::grid_group grid = cg::this_grid();
  __shared__ __attribute__((aligned(16))) char smem_dyn[131072];
  const int half = __builtin_amdgcn_readfirstlane((int)(threadIdx.x >> 8));
  char* const smem = smem_dyn + half * 65536;
  const int nph = 1 + 4 * NPH_LAYER + 1;
  const int G = gridDim.x;
  unsigned* const xbar = (unsigned*)(p0.ws + OFF_BAR);
  const unsigned xcc = xb_xcc_id();
  if (threadIdx.x == 0) ((volatile unsigned*)smem_dyn)[0] = xb_add(&xbar[XB_XCNT(xcc)], 1u);
  __syncthreads();
  const unsigned xrank = (unsigned)__builtin_amdgcn_readfirstlane((int)((volatile unsigned*)smem_dyn)[0]);
  __syncthreads();
  unsigned xb_nloc = 1u, xb_nx = 1u;
  int VB = blockIdx.x;
  bool second_half = false;

  for (int ph = 0; ph < nph; ++ph) {
    Params p = p0;
    {
      char* w = p0.ws;
      asm volatile("" : "+s"(w));
      p.ws = w;
    }
    int B = (ph == 0) ? (int)blockIdx.x : VB;
    asm volatile("" : "+s"(B));
    bf16_t* const WIN = (bf16_t*)(p.ws + OFF_WIN);
    bf16_t* const HN = (bf16_t*)(p.ws + OFF_HN);
    bf16_t* const PA1 = (bf16_t*)(p.ws + OFF_PA1);
    bf16_t* const PA2 = (bf16_t*)(p.ws + OFF_PA2);
    bf16_t* const HT = (bf16_t*)(p.ws + OFF_HT);
    if (ph == 0) {
      for (int j = 2 * B + half; j < 192 + 8448 + 64 + 512; j += 2 * G) {
        if (j < 192) job_mods(p, j, smem);
        else if (j < 192 + 8448) job_hid(p, j - 192, smem);
        else if (j < 192 + 8448 + 64) job_tw(p, j - 192 - 8448);
        else job_rope(p, j - 192 - 8448 - 64);
      }
    } else if (ph == nph - 1) {
      for (int j = 2 * B + half; j < 8192; j += 2 * G) {
        const int tid_ = get_tid(), lane = tid_ & 63, wave = tid_ >> 6;
        float* xr = p.out + (size_t)(j * 4 + wave) * 1024;
        f32x4 xv[4];
        float ss = 0.f;
#pragma unroll
        for (int i = 0; i < 4; ++i) {
          xv[i] = *(const f32x4*)(xr + lane * 4 + 256 * i);
          ss += xv[i][0] * xv[i][0] + xv[i][1] * xv[i][1] + xv[i][2] * xv[i][2] + xv[i][3] * xv[i][3];
        }
        ss = wave_sum(ss);
        const float rstd = rsqrtf(ss * (1.0f / 1024.0f) + 1e-6f);
#pragma unroll
        for (int i = 0; i < 4; ++i) {
          const int col = lane * 4 + 256 * i;
          float4 gg = *(const float4*)(p.final_g + col);
          float4 o = make_float4(xv[i][0] * rstd * gg.x, xv[i][1] * rstd * gg.y, xv[i][2] * rstd * gg.z, xv[i][3] * rstd * gg.w);
          *(float4*)(xr + col) = o;
        }
      }
    } else {
      const int q = ph - 1, layer = q / NPH_LAYER, r = q % NPH_LAYER;
      if (r == 0) {
        for (int j = 2 * B + half; j < 2872 + 1056; j += 2 * G) {
          if (j < 2096) {
            const int nt = j / 16, kt = j % 16;
            int nv = 8352 - nt * 64; nv = nv > 64 ? 64 : nv;
            tr_tile(p.w_in + (size_t)layer * 1024 * 8352 + nt * 64, 8352, nv, kt * 64, WIN + (size_t)nt * 64 * 1024, 1024, smem);
          } else if (j < 2096 + 384) {
            const int jj = j - 2096, which = jj / 128, q2 = jj % 128, nt = q2 / 8, kt = q2 % 8;
            const float* src = (which == 0 ? p.sc_out : which == 1 ? p.hy_out : p.mla_out) + (size_t)layer * 512 * 1024 + nt * 64;
            bf16_t* dst = (bf16_t*)(p.ws + (which == 0 ? OFF_WSC : which == 1 ? OFF_WHY : OFF_WMLA)) + (size_t)nt * 64 * 512;
            tr_tile(src, 1024, 64, kt * 64, dst, 512, smem);
          } else if (j < 2096 + 384 + 256) {
            const int jj = j - 2480, nt = jj / 16, kt = jj % 16;
            tr_tile(p.w_o + (size_t)layer * 1024 * 1024 + nt * 64, 1024, 64, kt * 64, (bf16_t*)(p.ws + OFF_WO) + (size_t)nt * 64 * 1024, 1024, smem);
          } else if (j < 2736 + 72) {
            const int jj = j - 2736, nt = jj / 6, kt = jj % 6;
            tr_tile(p.mla_w_uq + (size_t)layer * 384 * 768 + nt * 64, 768, 64, kt * 64, (bf16_t*)(p.ws + OFF_WUQ) + (size_t)nt * 64 * 384, 384, smem);
          } else if (j < 2808 + 64) {
            const int jj = j - 2808, nt = jj / 4, kt = jj % 4, hh = nt >> 1, half = nt & 1;
            bf16_t* dst = (bf16_t*)(p.ws + (half ? OFF_WV : OFF_WKN)) + (size_t)hh * 64 * 256;
            tr_tile(p.mla_w_ukv + (size_t)layer * 256 * 1024 + nt * 64, 1024, 64, kt * 64, dst, 256, smem);
          } else {
            job_hgen(p, layer, j - 2872, smem);
          }
        }
      } else {
        const int pass = (r <= 8) ? 0 : 1, sub = (r <= 8) ? r - 1 : r - 8;
        if (sub == 0) {
          for (int j = 2 * B + half; j < 1024; j += 2 * G) job_filtfft(p, j, smem);
          if (layer == 0)
            for (int j = 2 * B + half; j < T2 / 4; j += 2 * G) job_modnorm(p, 0, 0, j);
        } else if (sub >= 1 && sub <= 4) {
          const float* bin = p.b_in + layer * 8352;
          const int nF = (sub >= 3) ? 512 : 0;
          const int nC = (sub == 2 || sub == 4) ? 1024 : 0;
          const int whichF = sub - 3, whichC = (sub == 2) ? 0 : 1;
          const int nG = (sub == 1) ? 1716 : (sub == 3) ? 462 : 0;
          const int nA = (sub == 4) ? 528 : 0;
          const int nE = (sub == 2) ? 2112 : 0;
          const bool fft_first = true;
          for (int ord = 0; ord < 2; ++ord) {
            if ((ord == 0) == fft_first) {
              for (int j = 2 * B + half; j < nF; j += 2 * G) job_fftconv(p, layer, j, whichF, smem);
              for (int j = 2 * B + half; j < nC; j += 2 * G) job_ctxconv(p, layer, j >> 1, j & 1, whichC, smem);
            } else {
              for (int j = 2 * B + half; j < nE; j += 2 * G) {
                if (j < 1056) job_mlanorm(p, layer, j);
                else job_shortconv(p, layer, j - 1056);
              }
              for (int j = B; j < nA; j += G) {
                const bool ic = j >= 512;
                const int jj = j - 512;
                job_attn(p, ic ? (jj >> 3) : (j >> 8), ic ? (jj & 7) : ((j >> 5) & 7), ic ? 0 : (j & 31), ic, smem_dyn);
              }
              for (int j = B; j < nG; j += G) {
                if (sub == 1 && j >= 1056) {
                  const int jj = j - 1056;
                  const int m0 = (jj / 10) * 256, n0 = (jj % 10) * 128;
                  f32x4 acc[4][4];
#pragma unroll
                  for (int mi = 0; mi < 4; ++mi)
#pragma unroll
                    for (int ni = 0; ni < 4; ++ni) acc[mi][ni] = f32x4{0.f, 0.f, 0.f, 0.f};
                  gemm_t512<4, 4, 2>(HN, 1024, WIN + (size_t)4096 * 1024, 1024, 1024, m0, n0, 1184, acc, smem_dyn);
                  const int t5 = get_tid512(), l5 = t5 & 63, w5 = t5 >> 6, g5 = l5 >> 4;
#pragma unroll
                  for (int mi = 0; mi < 4; ++mi)
#pragma unroll
                    for (int ni2 = 0; ni2 < 4; ni2 += 2) {
                      const int row = m0 + (w5 >> 1) * 64 + mi * 16 + (l5 & 15);
                      const int colA = n0 + (w5 & 1) * 64 + ni2 * 16 + g5 * 4;
                      const float4 ba = *(const float4*)(bin + 4096 + colA), bb = *(const float4*)(bin + 4096 + colA + 16);
                      f32x4 va = acc[mi][ni2], vb = acc[mi][ni2 + 1];
                      va[0] += ba.x; va[1] += ba.y; va[2] += ba.z; va[3] += ba.w;
                      vb[0] += bb.x; vb[1] += bb.y; vb[2] += bb.z; vb[3] += bb.w;
                      const unsigned x0 = pack2(va[0], va[1]), x1 = pack2(va[2], va[3]);
                      const unsigned y0 = pack2(vb[0], vb[1]), y1 = pack2(vb[2], vb[3]);
                      const u32x2 s0 = __builtin_amdgcn_permlane16_swap(x0, y0, false, false);
                      const u32x2 s1 = __builtin_amdgcn_permlane16_swap(x1, y1, false, false);
                      const int col = n0 + (w5 & 1) * 64 + (ni2 + (g5 & 1)) * 16 + (g5 >> 1) * 8;
                      if (col < 1184) *(u32x4*)(PA2 + (size_t)row * 1184 + col) = u32x4{s0[0], s1[0], s0[1], s1[1]};
                    }
                  continue;
                }
                int kind, m0, n0, lda, ldb, K, nmax;
                const bf16_t *Ap, *Bp;
                if (sub == 1) {
                  if (j < 528) { kind = 0; m0 = (j >> 3) * 256; n0 = (j & 7) * 256; Ap = HN; lda = 1024; Bp = WIN; ldb = 1024; K = 1024; nmax = 2048; }
                  else { const int jj = j - 528; kind = 2; m0 = (jj & 7) * 256; n0 = (jj >> 3) * 256; Ap = WIN + (size_t)2048 * 1024; lda = 1024; Bp = HN; ldb = 1024; K = 1024; nmax = T2; }
                } else {
                  if (j < 198) { kind = 3; m0 = (j / 3) * 256; n0 = (j % 3) * 256; Ap = PA2; lda = 1184; Bp = (const bf16_t*)(p.ws + OFF_WUQ); ldb = 384; K = 384; nmax = 768; }
                  else if (j < 330) { const int j3 = j - 198; kind = 4; m0 = (j3 >> 1) * 256; n0 = (j3 & 1) * 256; Ap = PA2 + 384; lda = 1184; Bp = (const bf16_t*)(p.ws + OFF_WKN); ldb = 256; K = 256; nmax = 512; }
                  else { const int j3 = j - 330; kind = 5; m0 = (j3 & 1) * 256; n0 = (j3 >> 1) * 256; Ap = (const bf16_t*)(p.ws + OFF_WV); lda = 256; Bp = PA2 + 384; ldb = 1184; K = 256; nmax = T2; }
                }
                f32x4 acc[8][4];
#pragma unroll
                for (int mi = 0; mi < 8; ++mi)
#pragma unroll
                  for (int ni = 0; ni < 4; ++ni) acc[mi][ni] = f32x4{0.f, 0.f, 0.f, 0.f};
                gemm_t512<8, 4, 4>(Ap, lda, Bp, ldb, K, m0, n0, nmax, acc, smem_dyn);
                const int t5 = get_tid512(), l5 = t5 & 63, w5 = t5 >> 6, g5 = l5 >> 4;
#pragma unroll
                for (int mi = 0; mi < 8; ++mi)
#pragma unroll
                  for (int ni2 = 0; ni2 < 4; ni2 += 2) {
                    const int row = m0 + (w5 >> 2) * 128 + mi * 16 + (l5 & 15);
                    const int colA = n0 + (w5 & 3) * 64 + ni2 * 16 + g5 * 4;
                    f32x4 va = acc[mi][ni2], vb = acc[mi][ni2 + 1];
                    if (kind == 0) {
                      const float4 ba = *(const float4*)(bin + colA), bb = *(const float4*)(bin + colA + 16);
                      va[0] += ba.x; va[1] += ba.y; va[2] += ba.z; va[3] += ba.w;
                      vb[0] += bb.x; vb[1] += bb.y; vb[2] += bb.z; vb[3] += bb.w;
                    } else if (kind == 2) {
                      const float bsc = bin[2048 + row];
                      va += bsc;
                      vb += bsc;
                    }
                    const unsigned x0 = pack2(va[0], va[1]), x1 = pack2(va[2], va[3]);
                    const unsigned y0 = pack2(vb[0], vb[1]), y1 = pack2(vb[2], vb[3]);
                    const u32x2 s0 = __builtin_amdgcn_permlane16_swap(x0, y0, false, false);
                    const u32x2 s1 = __builtin_amdgcn_permlane16_swap(x1, y1, false, false);
                    const u32x4 o = {s0[0], s1[0], s0[1], s1[1]};
                    const int col = n0 + (w5 & 3) * 64 + (ni2 + (g5 & 1)) * 16 + (g5 >> 1) * 8;
                    bf16_t* dst;
                    if (kind == 0) dst = PA1 + (size_t)row * 2048 + col;
                    else if (kind == 2) dst = HT + (size_t)row * T2 + col;
                    else if (kind == 3) dst = (bf16_t*)(p.ws + OFF_Q) + (size_t)row * 768 + col;
                    else if (kind == 4) dst = (bf16_t*)(p.ws + OFF_KF) + (size_t)row * 768 + (col >> 6) * 96 + (col & 63);
                    else dst = (bf16_t*)(p.ws + OFF_VT) + (size_t)row * T2 + col;
                    *(u32x4*)dst = o;
                  }
              }
            }
          }
        } else if (sub == 5) {
          for (int j = 2 * B + half; j < 2112; j += 2 * G) job_tr_ah(p, j, smem);
        } else if (sub == 6) {
          const float* bin = p.b_in + layer * 8352 + 5280;
          bf16_t* Y = PA1;
          for (int j = B; j < 512; j += G) {
            const int m0 = (j >> 3) * 256, n0 = (j & 7) * 128;
            const int t5 = get_tid512(), l5 = t5 & 63, w5 = t5 >> 6;
            u32x2 yp[4][4];
#pragma unroll
            for (int mi = 0; mi < 4; ++mi)
#pragma unroll
              for (int ni = 0; ni < 4; ++ni) yp[mi][ni] = u32x2{0u, 0u};
            for (int br = 0; br < 3; ++br) {
              const bf16_t* Abr = (const bf16_t*)(p.ws + (br == 0 ? OFF_AA : br == 1 ? OFF_PA1 + 34603008 : OFF_AM));
              const bf16_t* Wbr = (const bf16_t*)(p.ws + (br == 0 ? OFF_WSC : br == 1 ? OFF_WHY : OFF_WMLA));
              u32x2 tp[4][4];
              {
                f32x4 t[4][4];
#pragma unroll
                for (int mi = 0; mi < 4; ++mi)
#pragma unroll
                  for (int ni = 0; ni < 4; ++ni) t[mi][ni] = f32x4{0.f, 0.f, 0.f, 0.f};
                gemm_t512<4, 4, 2>(Abr, 512, Wbr, 512, 512, m0, n0, 1024, t, smem_dyn);
#pragma unroll
                for (int mi = 0; mi < 4; ++mi)
#pragma unroll
                  for (int ni = 0; ni < 4; ++ni) { tp[mi][ni][0] = pack2(t[mi][ni][0], t[mi][ni][1]); tp[mi][ni][1] = pack2(t[mi][ni][2], t[mi][ni][3]); }
              }
              f32x4 ga[4][4];
#pragma unroll
              for (int mi = 0; mi < 4; ++mi)
#pragma unroll
                for (int ni = 0; ni < 4; ++ni) ga[mi][ni] = f32x4{0.f, 0.f, 0.f, 0.f};
              gemm_t512<4, 4, 2>(HN, 1024, WIN + (size_t)(5280 + br * 1024) * 1024, 1024, 1024, m0, n0, 1024, ga, smem_dyn);
#pragma unroll
              for (int mi = 0; mi < 4; ++mi)
#pragma unroll
                for (int ni = 0; ni < 4; ++ni) {
                  const int col = n0 + (w5 & 1) * 64 + ni * 16 + (l5 >> 4) * 4;
                  float4 b = *(const float4*)(bin + br * 1024 + col);
                  const float y0 = lo2f(yp[mi][ni][0]) + sigm_f(ga[mi][ni][0] + b.x) * lo2f(tp[mi][ni][0]);
                  const float y1 = hi2f(yp[mi][ni][0]) + sigm_f(ga[mi][ni][1] + b.y) * hi2f(tp[mi][ni][0]);
                  const float y2 = lo2f(yp[mi][ni][1]) + sigm_f(ga[mi][ni][2] + b.z) * lo2f(tp[mi][ni][1]);
                  const float y3 = hi2f(yp[mi][ni][1]) + sigm_f(ga[mi][ni][3] + b.w) * hi2f(tp[mi][ni][1]);
                  yp[mi][ni][0] = pack2(y0, y1);
                  yp[mi][ni][1] = pack2(y2, y3);
                }
            }
#pragma unroll
            for (int mi = 0; mi < 4; ++mi)
#pragma unroll
              for (int ni2 = 0; ni2 < 4; ni2 += 2) {
                const int g5 = l5 >> 4;
                const int row = m0 + (w5 >> 1) * 64 + mi * 16 + (l5 & 15);
                const u32x2 s0 = __builtin_amdgcn_permlane16_swap(yp[mi][ni2][0], yp[mi][ni2 + 1][0], false, false);
                const u32x2 s1 = __builtin_amdgcn_permlane16_swap(yp[mi][ni2][1], yp[mi][ni2 + 1][1], false, false);
                const int col = n0 + (w5 & 1) * 64 + (ni2 + (g5 & 1)) * 16 + (g5 >> 1) * 8;
                *(u32x4*)(Y + (size_t)row * 1024 + col) = u32x4{s0[0], s1[0], s0[1], s1[1]};
              }
          }
          for (int j = 2048 + 2 * B + half; j < 2112; j += 2 * G) {
            int t132, t16;
            { const int inner = j - 2048; t132 = 128 + (inner & 3); t16 = inner >> 2; }
            const int m0 = t132 * 128, n0 = t16 * 64;
            f32x4 y[4][2];
            zero_acc<2>(y);
            for (int br = 0; br < 3; ++br) {
              const bf16_t* Abr = (const bf16_t*)(p.ws + (br == 0 ? OFF_AA : br == 1 ? OFF_PA1 + 34603008 : OFF_AM));
              const bf16_t* Wbr = (const bf16_t*)(p.ws + (br == 0 ? OFF_WSC : br == 1 ? OFF_WHY : OFF_WMLA));
              f32x4 t[4][2], ga[4][2];
              zero_acc<2>(t);
              zero_acc<2>(ga);
              gemm_main<2>(Abr, 512, Wbr, 512, 512, m0, n0, 1024, t, smem);
              gemm_main<2>(HN, 1024, WIN + (size_t)(5280 + br * 1024) * 1024, 1024, 1024, m0, n0, 1024, ga, smem);
              EPI_LOOP(2) {
                const int col = EPI_COL(2);
                float4 b = *(const float4*)(bin + br * 1024 + col);
                y[mi][ni][0] += sigm_f(ga[mi][ni][0] + b.x) * t[mi][ni][0];
                y[mi][ni][1] += sigm_f(ga[mi][ni][1] + b.y) * t[mi][ni][1];
                y[mi][ni][2] += sigm_f(ga[mi][ni][2] + b.z) * t[mi][ni][2];
                y[mi][ni][3] += sigm_f(ga[mi][ni][3] + b.w) * t[mi][ni][3];
              }
            }
            EPI_LOOP(2) {
              const int row = EPI_ROW, col = EPI_COL(2);
              store_bf4(Y + (size_t)row * 1024 + col, y[mi][ni]);
            }
          }
        } else {
          for (int j = B; j < 256; j += G) {
            const int m0 = (j >> 2) * 256, n0 = (j & 3) * 256;
            const int t5 = get_tid512(), l5 = t5 & 63, w5 = t5 >> 6;
            f32x4 acc[8][4];
#pragma unroll
            for (int mi = 0; mi < 8; ++mi)
#pragma unroll
              for (int ni = 0; ni < 4; ++ni) acc[mi][ni] = f32x4{0.f, 0.f, 0.f, 0.f};
            gemm_t512<8, 4, 4>(PA1, 1024, (const bf16_t*)(p.ws + OFF_WO), 1024, 1024, m0, n0, 1024, acc, smem_dyn);
#pragma unroll
            for (int mi = 0; mi < 8; ++mi)
#pragma unroll
              for (int ni = 0; ni < 4; ++ni) {
                const int row = m0 + (w5 >> 2) * 128 + mi * 16 + (l5 & 15);
                const int col = n0 + (w5 & 3) * 64 + ni * 16 + (l5 >> 4) * 4;
                const int b = 2 * pass + (row >> 13), t = row & 8191;
                const size_t off = ((size_t)b * 8192 + t) * 1024 + col;
                const float* xi = (layer == 0 ? p.x : p.out) + off;
                float* xo = p.out + off;
                const float* gate = (const float*)(p.ws + OFF_MODS) + (layer * 5 + b) * 3072 + 2048 + col;
                float4 gt = *(const float4*)gate;
                float4 xv = *(const float4*)xi;
                float4 o = make_float4(xv.x + gt.x * acc[mi][ni][0], xv.y + gt.y * acc[mi][ni][1], xv.z + gt.z * acc[mi][ni][2],
                                       xv.w + gt.w * acc[mi][ni][3]);
                *(float4*)xo = o;
              }
          }
          for (int j = 2048 + 2 * B + half; j < 2112; j += 2 * G) {
            int t132, t16;
            { const int inner = j - 2048; t132 = 128 + (inner & 3); t16 = inner >> 2; }
            const int m0 = t132 * 128, n0 = t16 * 64;
            f32x4 acc[4][2];
            zero_acc<2>(acc);
            gemm_main<2>(PA1, 1024, (const bf16_t*)(p.ws + OFF_WO), 1024, 1024, m0, n0, 1024, acc, smem);
            EPI_LOOP(2) {
              const int row = EPI_ROW, col = EPI_COL(2);
              const float* xi;
              float* xo;
              int v;
              if (row < 16384) {
                const int b = 2 * pass + (row >> 13), t = row & 8191;
                const size_t off = ((size_t)b * 8192 + t) * 1024 + col;
                xi = (layer == 0 ? p.x : p.out) + off;
                xo = p.out + off;
                v = b;
              } else {
                const int qq = row - 16384;
                const int b = 2 * pass + (qq >> 8), t = qq & 255;
                const size_t off = ((size_t)b * 256 + t) * 1024 + col;
                xi = (layer == 0 ? p.ctx : (const float*)(p.ws + OFF_XCTX)) + off;
                xo = (float*)(p.ws + OFF_XCTX) + off;
                v = 4;
              }
              const float* gate = (const float*)(p.ws + OFF_MODS) + (layer * 5 + v) * 3072 + 2048 + col;
              float4 gt = *(const float4*)gate;
              float4 xv = *(const float4*)xi;
              float4 o = make_float4(xv.x + gt.x * acc[mi][ni][0], xv.y + gt.y * acc[mi][ni][1], xv.z + gt.z * acc[mi][ni][2],
                                     xv.w + gt.w * acc[mi][ni][3]);
              *(float4*)xo = o;
            }
          }
          {
            const int nl = (pass == 0) ? layer : layer + 1, np = pass ^ 1;
            if (nl < 4)
              for (int j = 2 * B + half; j < T2 / 4; j += 2 * G) job_modnorm(p, nl, np, j);
          }
        }
      }
    }
    if (ph == 0) {
      if (p0.ws == nullptr) grid.sync();
      {
        unsigned sp = 0u;
        for (;;) {
          unsigned sum = 0u;
#pragma unroll
          for (unsigned j = 0; j < 16; ++j) sum += xb_ld(&xbar[XB_XCNT(j)]);
          if (sum == (unsigned)G) break;
          __builtin_amdgcn_s_sleep(1);
          if (++sp > XB_SPIN_CAP) break;
        }
      }
      xb_census(xbar, xcc, xb_nloc, xb_nx);
      xb_nloc = (unsigned)__builtin_amdgcn_readfirstlane((int)xb_nloc);
      xb_nx = (unsigned)__builtin_amdgcn_readfirstlane((int)xb_nx);
      {
        unsigned base = 0u;
#pragma unroll
        for (unsigned j = 0; j < 16; ++j) {
          const unsigned cnt = xb_ld(&xbar[XB_XCNT(j)]);
          base += (j < xcc) ? cnt : 0u;
        }
        VB = __builtin_amdgcn_readfirstlane((int)(base + xrank));
        second_half = xrank >= (xb_nloc >> 1);
      }
      xcd_barrier(xbar, xcc, xb_nloc, xb_nx);
    } else if (ph + 1 < nph) {
      xcd_barrier(xbar, xcc, xb_nloc, xb_nx);
    }
  }
}

extern "C" void kernel_launch(void* const* d_in, const int* in_sizes, int n_in, void* d_out, int out_size, void* d_ws,
                              size_t ws_size, hipStream_t stream) {
  constexpr int kDynLds = 0;
  static int grid_blocks = 0;
  if (!grid_blocks) {
    int dev = 0, cus = 0, per_cu = 0;
    hipGetDevice(&dev);
    hipDeviceGetAttribute(&cus, hipDeviceAttributeMultiprocessorCount, dev);
    hipOccupancyMaxActiveBlocksPerMultiprocessor(&per_cu, mega, 512, kDynLds);
    if (per_cu > 1) per_cu = 1;
    if (per_cu < 1) per_cu = 1;
    grid_blocks = cus * per_cu;
  }
  Params p{};
  const float** pp = (const float**)&p;
  for (int i = 0; i < 29; ++i) pp[i] = (const float*)d_in[i];
  p.out = (float*)d_out;
  p.ws = (char*)d_ws;
  if (ws_size < WS_TOTAL) {
    fprintf(stderr, "workspace too small: %zu < %zu\n", ws_size, (size_t)WS_TOTAL);
    return;
  }
  (void)hipMemsetAsync((char*)d_ws + OFF_BAR, 0, 16384, stream);
  void* args[] = {&p};
  hipError_t e = hipLaunchCooperativeKernel((void*)mega, dim3(grid_blocks), dim3(512), args, kDynLds, stream);
  if (e != hipSuccess) fprintf(stderr, "coop launch failed: %s (grid %d)\n", hipGetErrorString(e), grid_blocks);
}
```
